# Optimizing an MI355X kernel written in HIP

```python
import math
import jax, jax.numpy as jnp
from jax import lax
import numpy as np


D_MODEL = 1024
BATCH = 8
SEQ = 2048
DEPTH = 1
DEC_BATCH = 16
DEC_SEQ = 64
PAST_LEN = 4096

CHUNK = 64
PLE_DIM = 256
SB_WIDTH = D_MODEL // 2
SB_HEAD_DIM = 64
SB_HEADS = SB_WIDTH // SB_HEAD_DIM
SB_BLOCK = 128
SSM_WIDTH = D_MODEL // 2
SSM_GROUP = 16
SSM_GROUPS = SSM_WIDTH // SSM_GROUP
SSM_STATE = 64
D_FF = -(-8 * D_MODEL // (3 * 256)) * 256
IN_WIDTH = 3 * SB_WIDTH + SSM_WIDTH + 2 * D_MODEL
RMS_EPS = 1e-6

kernel_name = 'stickbreak_s5_streaming_step'


def _rmsnorm(x, gain):
    xf = x.astype(jnp.float32)
    y = xf * lax.rsqrt(jnp.mean(xf * xf, axis=-1, keepdims=True) + RMS_EPS)
    return (y * gain.astype(jnp.float32)).astype(x.dtype)


def _sb_block(qb, start, k, v, q_offset):
    z = jnp.einsum('bqhd,bkhd->bhqk', qb, k) * (SB_HEAD_DIM ** -0.5)
    t_pos = q_offset + start + jnp.arange(qb.shape[1])
    s_pos = jnp.arange(k.shape[1])
    visible = s_pos[None, :] < t_pos[:, None]
    log_keep = jnp.where(visible, jax.nn.log_sigmoid(-z), 0.0)
    after = lax.cumsum(log_keep, axis=3, reverse=True) - log_keep
    w = jnp.where(visible, jnp.exp(jax.nn.log_sigmoid(z) + after), 0.0)
    return jnp.einsum('bhqk,bkhd->bqhd', w, v)


def _stick_breaking(q, k, v, q_offset):
    bsz, lq = q.shape[0], q.shape[1]
    blk = min(SB_BLOCK, lq)
    nb = lq // blk
    qf = q.astype(jnp.float32).reshape(bsz, nb, blk, SB_HEADS, SB_HEAD_DIM)
    qf = jnp.moveaxis(qf, 1, 0)
    kf = k.astype(jnp.float32)
    vf = v.astype(jnp.float32)
    starts = jnp.arange(nb) * blk
    out = lax.map(lambda a: _sb_block(a[0], a[1], kf, vf, q_offset), (qf, starts))
    return jnp.moveaxis(out, 0, 1).reshape(bsz, lq, SB_HEADS, SB_HEAD_DIM)


def _s5(u, s_re0, s_im0, a_re, a_im, log_dt, b_re, b_im, c_re, c_im, d, w_glu):
    bsz, L, _ = u.shape
    uf = u.astype(jnp.float32).reshape(bsz, L, SSM_GROUPS, SSM_GROUP)
    a_re = a_re.astype(jnp.float32)
    a_im = a_im.astype(jnp.float32)
    dt = jnp.exp(log_dt.astype(jnp.float32))[:, None]
    mag = jnp.exp(a_re * dt)
    lb_re = mag * jnp.cos(a_im * dt)
    lb_im = mag * jnp.sin(a_im * dt)
    den = a_re * a_re + a_im * a_im
    nr, ni = lb_re - 1.0, lb_im
    f_re = (nr * a_re + ni * a_im) / den
    f_im = (ni * a_re - nr * a_im) / den
    b_re = b_re.astype(jnp.float32)
    b_im = b_im.astype(jnp.float32)
    bb_re = f_re[:, :, None] * b_re - f_im[:, :, None] * b_im
    bb_im = f_re[:, :, None] * b_im + f_im[:, :, None] * b_re
    bu_re = jnp.einsum('gpc,btgc->btgp', bb_re, uf)
    bu_im = jnp.einsum('gpc,btgc->btgp', bb_im, uf)
    s_re0 = s_re0.astype(jnp.float32)
    s_im0 = s_im0.astype(jnp.float32)
    bu_re = bu_re.at[:, 0].add(lb_re * s_re0 - lb_im * s_im0)
    bu_im = bu_im.at[:, 0].add(lb_re * s_im0 + lb_im * s_re0)
    ar = jnp.broadcast_to(lb_re, bu_re.shape)
    ai = jnp.broadcast_to(lb_im, bu_im.shape)

    def combine(e1, e2):
        ar1, ai1, br1, bi1 = e1
        ar2, ai2, br2, bi2 = e2
        return (ar2 * ar1 - ai2 * ai1,
                ar2 * ai1 + ai2 * ar1,
                ar2 * br1 - ai2 * bi1 + br2,
                ar2 * bi1 + ai2 * br1 + bi2)

    _, _, s_re, s_im = lax.associative_scan(combine, (ar, ai, bu_re, bu_im), axis=1)
    y = (jnp.einsum('gcp,btgp->btgc', c_re.astype(jnp.float32), s_re)
         - jnp.einsum('gcp,btgp->btgc', c_im.astype(jnp.float32), s_im)
         + d.astype(jnp.float32).reshape(SSM_GROUPS, SSM_GROUP) * uf)
    y = jax.nn.gelu(y.reshape(bsz, L, SSM_WIDTH))
    y = y * jax.nn.sigmoid(y @ w_glu.astype(jnp.float32))
    return y.astype(u.dtype), s_re[:, -1], s_im[:, -1]


def _layer(x, p, k_past, v_past, s_re0, s_im0, W):
    bsz, L, _ = x.shape
    h = _rmsnorm(x, W['norm_mix_pre'])
    proj = h @ W['w_in']
    q, k, v, u, g_attn, g_ssm = jnp.split(
        proj, [SB_WIDTH, 2 * SB_WIDTH, 3 * SB_WIDTH, 3 * SB_WIDTH + SSM_WIDTH,
               3 * SB_WIDTH + SSM_WIDTH + D_MODEL], axis=-1)
    q = q.reshape(bsz, L, SB_HEADS, SB_HEAD_DIM)
    k = k.reshape(bsz, L, SB_HEADS, SB_HEAD_DIM)
    v = v.reshape(bsz, L, SB_HEADS, SB_HEAD_DIM)
    if k_past is None:
        k_all, v_all, q_offset = k, v, 0
    else:
        k_all = jnp.concatenate([k_past, k.astype(k_past.dtype)], axis=1)
        v_all = jnp.concatenate([v_past, v.astype(v_past.dtype)], axis=1)
        q_offset = k_past.shape[1]
    o_attn = _stick_breaking(q, k_all, v_all, q_offset).reshape(bsz, L, SB_WIDTH).astype(x.dtype)
    o_ssm, s_re, s_im = _s5(u, s_re0, s_im0, W['ssm_a_re'], W['ssm_a_im'], W['ssm_log_dt'],
                            W['ssm_b_re'], W['ssm_b_im'], W['ssm_c_re'], W['ssm_c_im'],
                            W['ssm_d'], W['w_glu'])
    merged = (jax.nn.sigmoid(g_attn) * (o_attn @ W['w_branch_attn'])
              + jax.nn.sigmoid(g_ssm) * (o_ssm @ W['w_branch_ssm']))
    x = x + _rmsnorm(merged @ W['w_out'], W['norm_mix_post'])
    f = _rmsnorm(x, W['norm_ffn_pre'])
    f = (jax.nn.silu(f @ W['w_ffn_gate']) * (f @ W['w_ffn_up'])) @ W['w_ffn_down']
    x = x + _rmsnorm(f, W['norm_ffn_post'])
    gate = jax.nn.sigmoid(_rmsnorm(x, W['norm_ple_pre']) @ W['w_ple_gate'])
    pe = gate * (p @ W['w_ple_proj'])
    x = x + _rmsnorm(pe, W['norm_ple_post'])
    return x, k, v, s_re, s_im


def setup_inputs(seed: int = 0) -> dict:
    key = jax.random.key(seed)
    ks = iter(jax.random.split(key, 40))
    f32 = jnp.float32

    def nrm(shape, fan_in):
        return jax.random.normal(next(ks), shape, f32) * (fan_in ** -0.5)

    def gain(shape):
        return 1.0 + 0.05 * jax.random.normal(next(ks), shape, f32)

    a_im_base = math.pi * jnp.arange(SSM_STATE, dtype=f32)
    return {
        'x_prompt': jax.random.normal(next(ks), (BATCH, SEQ, D_MODEL), f32),
        'x_sample': jax.random.normal(next(ks), (DEC_BATCH, DEC_SEQ, D_MODEL), f32),
        'cache_k': jax.random.normal(next(ks), (DEPTH, DEC_BATCH, PAST_LEN, SB_HEADS, SB_HEAD_DIM), f32),
        'cache_v': jax.random.normal(next(ks), (DEPTH, DEC_BATCH, PAST_LEN, SB_HEADS, SB_HEAD_DIM), f32),
        'state_ssm_re': 0.3 * jax.random.normal(next(ks), (DEPTH, DEC_BATCH, SSM_GROUPS, SSM_STATE), f32),
        'state_ssm_im': 0.3 * jax.random.normal(next(ks), (DEPTH, DEC_BATCH, SSM_GROUPS, SSM_STATE), f32),
        'p_prompt': jax.random.normal(next(ks), (DEPTH, BATCH, SEQ, PLE_DIM), f32),
        'p_sample': jax.random.normal(next(ks), (DEPTH, DEC_BATCH, DEC_SEQ, PLE_DIM), f32),
        'norm_mix_pre': gain((DEPTH, D_MODEL)),
        'norm_mix_post': gain((DEPTH, D_MODEL)),
        'w_in': nrm((DEPTH, D_MODEL, IN_WIDTH), D_MODEL),
        'ssm_a_re': -0.5 + 0.01 * jax.random.normal(next(ks), (DEPTH, SSM_GROUPS, SSM_STATE), f32),
        'ssm_a_im': a_im_base + 0.01 * jax.random.normal(next(ks), (DEPTH, SSM_GROUPS, SSM_STATE), f32),
        'ssm_log_dt': jax.random.uniform(next(ks), (DEPTH, SSM_GROUPS), f32,
                                         minval=math.log(1e-3), maxval=math.log(1e-1)),
        'ssm_b_re': nrm((DEPTH, SSM_GROUPS, SSM_STATE, SSM_GROUP), SSM_GROUP),
        'ssm_b_im': nrm((DEPTH, SSM_GROUPS, SSM_STATE, SSM_GROUP), SSM_GROUP),
        'ssm_c_re': nrm((DEPTH, SSM_GROUPS, SSM_GROUP, SSM_STATE), SSM_STATE),
        'ssm_c_im': nrm((DEPTH, SSM_GROUPS, SSM_GROUP, SSM_STATE), SSM_STATE),
        'ssm_d': jax.random.normal(next(ks), (DEPTH, SSM_WIDTH), f32),
        'w_glu': nrm((DEPTH, SSM_WIDTH, SSM_WIDTH), SSM_WIDTH),
        'w_branch_attn': nrm((DEPTH, SB_WIDTH, D_MODEL), SB_WIDTH),
        'w_branch_ssm': nrm((DEPTH, SSM_WIDTH, D_MODEL), SSM_WIDTH),
        'w_out': nrm((DEPTH, D_MODEL, D_MODEL), D_MODEL),
        'norm_ffn_pre': gain((DEPTH, D_MODEL)),
        'norm_ffn_post': gain((DEPTH, D_MODEL)),
        'w_ffn_gate': nrm((DEPTH, D_MODEL, D_FF), D_MODEL),
        'w_ffn_up': nrm((DEPTH, D_MODEL, D_FF), D_MODEL),
        'w_ffn_down': nrm((DEPTH, D_FF, D_MODEL), D_FF),
        'norm_ple_pre': gain((DEPTH, D_MODEL)),
        'norm_ple_post': gain((DEPTH, D_MODEL)),
        'w_ple_gate': nrm((DEPTH, D_MODEL, D_MODEL), D_MODEL),
        'w_ple_proj': nrm((DEPTH, PLE_DIM, D_MODEL), PLE_DIM),
    }


def reference(x_prompt, x_sample, cache_k, cache_v, state_ssm_re, state_ssm_im, p_prompt, p_sample,
              norm_mix_pre, norm_mix_post, w_in, ssm_a_re, ssm_a_im, ssm_log_dt, ssm_b_re, ssm_b_im,
              ssm_c_re, ssm_c_im, ssm_d, w_glu, w_branch_attn, w_branch_ssm, w_out,
              norm_ffn_pre, norm_ffn_post, w_ffn_gate, w_ffn_up, w_ffn_down,
              norm_ple_pre, norm_ple_post, w_ple_gate, w_ple_proj):
    yp, ys = x_prompt, x_sample
    kp_l, vp_l, srp_l, sip_l = [], [], [], []
    ks_l, vs_l, srs_l, sis_l = [], [], [], []
    for i in range(DEPTH):
        W = dict(norm_mix_pre=norm_mix_pre[i], norm_mix_post=norm_mix_post[i], w_in=w_in[i],
                 ssm_a_re=ssm_a_re[i], ssm_a_im=ssm_a_im[i], ssm_log_dt=ssm_log_dt[i],
                 ssm_b_re=ssm_b_re[i], ssm_b_im=ssm_b_im[i], ssm_c_re=ssm_c_re[i], ssm_c_im=ssm_c_im[i],
                 ssm_d=ssm_d[i], w_glu=w_glu[i], w_branch_attn=w_branch_attn[i],
                 w_branch_ssm=w_branch_ssm[i], w_out=w_out[i],
                 norm_ffn_pre=norm_ffn_pre[i], norm_ffn_post=norm_ffn_post[i],
                 w_ffn_gate=w_ffn_gate[i], w_ffn_up=w_ffn_up[i], w_ffn_down=w_ffn_down[i],
                 norm_ple_pre=norm_ple_pre[i], norm_ple_post=norm_ple_post[i],
                 w_ple_gate=w_ple_gate[i], w_ple_proj=w_ple_proj[i])
        zero_state = jnp.zeros((x_prompt.shape[0], SSM_GROUPS, SSM_STATE), jnp.float32)
        yp, kp, vp, srp, sip = _layer(yp, p_prompt[i], None, None, zero_state, zero_state, W)
        ys, kn, vn, srs, sis = _layer(ys, p_sample[i], cache_k[i], cache_v[i],
                                      state_ssm_re[i], state_ssm_im[i], W)
        kp_l.append(kp); vp_l.append(vp); srp_l.append(srp); sip_l.append(sip)
        ks_l.append(kn); vs_l.append(vn); srs_l.append(srs); sis_l.append(sis)
    k_prompt = jnp.stack(kp_l)
    v_prompt = jnp.stack(vp_l)
    ssm_re_prompt = jnp.stack(srp_l)
    ssm_im_prompt = jnp.stack(sip_l)
    k_sample = jnp.stack(ks_l)
    v_sample = jnp.stack(vs_l)
    ssm_re_sample = jnp.stack(srs_l)
    ssm_im_sample = jnp.stack(sis_l)
    return (yp, ys, k_prompt, v_prompt, ssm_re_prompt, ssm_im_prompt,
            k_sample, v_sample, ssm_re_sample, ssm_im_sample)
```

```cpp
#include <hip/hip_runtime.h>
#include <hip/hip_cooperative_groups.h>
#include <cstdio>
#include <cstdint>
namespace cg = cooperative_groups;

#define LAS __attribute__((address_space(3)))
typedef unsigned short bf16_t;
typedef short bf16x8 __attribute__((ext_vector_type(8)));
typedef float f32x4 __attribute__((ext_vector_type(4)));
typedef float f32x16 __attribute__((ext_vector_type(16)));
typedef unsigned u32x4 __attribute__((ext_vector_type(4)));
typedef unsigned u32x2 __attribute__((ext_vector_type(2)));

constexpr int MP = 16384, MS = 1024, M = MP + MS, NM = M / 256;
constexpr int D = 1024, DFF = 2816, SBW = 512, PLE = 256;
constexpr float EPS = 1e-6f;
constexpr size_t O_Y = 0, O_KP = 17825792, O_VP = 26214400, O_SRP = 34603008, O_SIP = 34619392, O_KS = 34635776, O_VS = 35160064, O_SRS = 35684352, O_SIS = 35717120;
constexpr size_t MiB = 1u << 20;
constexpr size_t WS_CTL = 0, CTL_BYTES = 1 * MiB;
constexpr size_t WS_SSQ1 = 64 * 1024, WS_SSQ2 = 192 * 1024, WS_SSQ3 = 320 * 1024;
constexpr size_t WS_WIN = 2 * MiB, WS_WGLU = 10 * MiB, WS_WBA = 11 * MiB, WS_WBS = 12 * MiB, WS_WOUT = 13 * MiB, WS_WGU = 15 * MiB, WS_WDN = 26 * MiB, WS_WPG = 32 * MiB, WS_WPP = 34 * MiB;
constexpr size_t WS_LB = 35 * MiB, WS_LB64 = WS_LB + 16 * 1024, WS_BB = WS_LB + 64 * 1024, WS_RS = WS_LB + 512 * 1024;
constexpr size_t WS_E = 36 * MiB;
constexpr size_t WS_XB = 40 * MiB, WS_Q = 74 * MiB, WS_U = 91 * MiB, WS_SGA = 125 * MiB, WS_SGS = 159 * MiB, WS_OA = 193 * MiB, WS_YS = 210 * MiB, WS_OS = 227 * MiB, WS_MG = 244 * MiB;
constexpr size_t WS_T = 278 * MiB, WS_PP = 346 * MiB, WS_PB = 380 * MiB, WS_END = 389 * MiB;
constexpr size_t WS_H = 74 * MiB;
static_assert(WS_H + (size_t)M * DFF * 2 <= WS_OA, "H overlay");
constexpr int LDS_BYTES = 147456;

struct Args { const float* in[32]; float* out; unsigned char* ws; };

__device__ __forceinline__ unsigned cvt_pk_bf16(float lo, float hi) { unsigned r; asm volatile("v_cvt_pk_bf16_f32 %0, %1, %2" : "=v"(r) : "v"(lo), "v"(hi)); return r; }
__device__ __forceinline__ unsigned f2bf(float f) { unsigned u = __builtin_bit_cast(unsigned, f); return (u + 0x7fffu + ((u >> 16) & 1u)) >> 16; }
__device__ __forceinline__ float bflo(unsigned w) { return __builtin_bit_cast(float, w << 16); }
__device__ __forceinline__ float bfhi(unsigned w) { return __builtin_bit_cast(float, w & 0xffff0000u); }
__device__ __forceinline__ u32x4 pack8(f32x4 a, f32x4 b) { u32x4 w; w.x = cvt_pk_bf16(a[0], a[1]); w.y = cvt_pk_bf16(a[2], a[3]); w.z = cvt_pk_bf16(b[0], b[1]); w.w = cvt_pk_bf16(b[2], b[3]); return w; }
__device__ __forceinline__ void unpack8(u32x4 w, f32x4& a, f32x4& b) { a = (f32x4){bflo(w.x), bfhi(w.x), bflo(w.y), bfhi(w.y)}; b = (f32x4){bflo(w.z), bfhi(w.z), bflo(w.w), bfhi(w.w)}; }
__device__ __forceinline__ float sigm(float x) { return __builtin_amdgcn_rcpf(1.0f + __expf(-x)); }
__device__ __forceinline__ f32x4 sigm4(f32x4 v) { return (f32x4){sigm(v[0]), sigm(v[1]), sigm(v[2]), sigm(v[3])}; }
__device__ __forceinline__ float wave_sum(float v) {
#pragma unroll
    for (int o = 1; o < 64; o <<= 1) v += __shfl_xor(v, o);
    return v;
}

namespace pg8 {
constexpr int BM = 256, BK = 64, HALF = 128, HTB = HALF * BK * 2, STAGE_BYTES = 8 * HTB, NXCD = 8, WGM = 8;
__device__ __forceinline__ int lds_byte(int r, int c) { const int st = (r >> 4) * 2 + (c >> 5), rr = r & 15, cc = c & 31, ob = rr * 64 + cc * 2; return st * 1024 + (ob ^ (((ob >> 9) & 1) << 5)); }
__device__ __forceinline__ void stage_rc(int b, int& R, int& C) { const int st = b / 1024, sb = b % 1024, swz = sb ^ (((sb >> 9) & 1) << 5); R = (st >> 1) * 16 + swz / 64; C = (st & 1) * 32 + (swz % 64) / 2; }
__device__ __forceinline__ int perm32(int rho) { const int n = rho >> 4, i = rho & 15; return 8 * (i >> 2) + 4 * n + (i & 3); }

enum { T_IN = 0, T_GLU, T_BA, T_PP, T_BS, T_OUT, T_GU, T_PG };
struct GUnit { const char* A; const char* Bt; int K, pm, pn, type; };
struct GDesc { const bf16_t* A; const bf16_t* Bt; int K, nN, type; };

__device__ __forceinline__ void map_unit(int L, const GDesc& d, GUnit& u) {
    const int nN = d.nN, nwg = NM * nN;
    int wgid = L; { const int q = nwg / NXCD, r = nwg % NXCD, xcd = wgid % NXCD, off = wgid / NXCD; wgid = (xcd < r ? xcd * (q + 1) : r * (q + 1) + (xcd - r) * q) + off; }
    const int nig = WGM * nN, gid = wgid / nig, fm = gid * WGM, gsz = (NM - fm) < WGM ? (NM - fm) : WGM;
    u.pm = fm + ((wgid % nig) % gsz); u.pn = (wgid % nig) / gsz; u.K = d.K; u.type = d.type;
    u.A = (const char*)d.A + (size_t)u.pm * 512 * d.K; u.Bt = (const char*)d.Bt + (size_t)u.pn * 512 * d.K;
}
struct Sched {
    GDesc d0, d1, d2; int nd, G, c;
    __device__ __forceinline__ bool next(int i, GUnit& u) const {
        long L = (long)i * G + c;
        const int n0 = NM * d0.nN; if (L < n0) { map_unit((int)L, d0, u); return true; } L -= n0;
        if (nd < 2) return false;
        const int n1 = NM * d1.nN; if (L < n1) { map_unit((int)L, d1, u); return true; } L -= n1;
        if (nd < 3) return false;
        const int n2 = NM * d2.nN; if (L < n2) { map_unit((int)L, d2, u); return true; }
        return false;
    }
};

template <int TMASK> struct Epi {
    float* out; unsigned char* ws; float* ssq;
    __device__ __forceinline__ void operator()(const f32x4 (&acc)[2][2][4][2], const GUnit& u, int wr, int wc, int fr, int fq) const {
        const int rowb = u.pm * 256 + wr * 64 + fr, colb = u.pn * 256 + wc * 32 + 8 * fq;
        const float* RS = (const float*)(ws + WS_RS);
        const int type = u.type, pn = u.pn;
#define HAS(t) (((TMASK >> (t)) & 1) && (TMASK == (1 << (t)) || type == (t)))
        if (HAS(T_IN)) {
            bf16_t* Qb = (bf16_t*)(ws + WS_Q); float* Ub = (float*)(ws + WS_U); bf16_t* SGA = (bf16_t*)(ws + WS_SGA); bf16_t* SGS = (bf16_t*)(ws + WS_SGS);
            const bool pr = u.pm < 64;
#pragma unroll
            for (int ai = 0; ai < 2; ++ai)
#pragma unroll
                for (int m = 0; m < 4; ++m) {
                    const int row = rowb + ai * 128 + m * 16; const float rs = RS[row];
                    float* kd = pr ? out + O_KP + (size_t)row * 512 : out + O_KS + (size_t)(row - MP) * 512;
                    float* vd = pr ? out + O_VP + (size_t)row * 512 : out + O_VS + (size_t)(row - MP) * 512;
#pragma unroll
                    for (int bj = 0; bj < 2; ++bj) {
                        const int col = colb + bj * 128; const f32x4 v0 = acc[ai][bj][m][0] * rs, v1 = acc[ai][bj][m][1] * rs;
                        if (pn < 2) *(u32x4*)(Qb + (size_t)row * 512 + col) = pack8(v0, v1);
                        else if (pn < 4) { float* p = kd + (col - 512); *(f32x4*)p = v0; *(f32x4*)(p + 4) = v1; }
                        else if (pn < 6) { float* p = vd + (col - 1024); *(f32x4*)p = v0; *(f32x4*)(p + 4) = v1; }
                        else if (pn < 8) { float* p = Ub + (size_t)row * 512 + (col - 1536); *(f32x4*)p = v0; *(f32x4*)(p + 4) = v1; }
                        else if (pn < 12) *(u32x4*)(SGA + (size_t)row * 1024 + (col - 2048)) = pack8(sigm4(v0), sigm4(v1));
                        else *(u32x4*)(SGS + (size_t)row * 1024 + (col - 3072)) = pack8(sigm4(v0), sigm4(v1));
                    }
                }
        } else if (HAS(T_GLU)) {
            const bf16_t* YS = (const bf16_t*)(ws + WS_YS); bf16_t* OS = (bf16_t*)(ws + WS_OS);
#pragma unroll
            for (int ai = 0; ai < 2; ++ai)
#pragma unroll
                for (int m = 0; m < 4; ++m) {
                    const int row = rowb + ai * 128 + m * 16;
#pragma unroll
                    for (int bj = 0; bj < 2; ++bj) {
                        const size_t o = (size_t)row * 512 + colb + bj * 128; f32x4 y0, y1; unpack8(*(const u32x4*)(YS + o), y0, y1);
                        *(u32x4*)(OS + o) = pack8(y0 * sigm4(acc[ai][bj][m][0]), y1 * sigm4(acc[ai][bj][m][1]));
                    }
                }
        } else if (HAS(T_BA)) {
            const bf16_t* SGA = (const bf16_t*)(ws + WS_SGA); bf16_t* MG = (bf16_t*)(ws + WS_MG);
#pragma unroll
            for (int ai = 0; ai < 2; ++ai)
#pragma unroll
                for (int m = 0; m < 4; ++m) {
                    const int row = rowb + ai * 128 + m * 16;
#pragma unroll
                    for (int bj = 0; bj < 2; ++bj) {
                        const size_t o = (size_t)row * 1024 + colb + bj * 128; f32x4 g0, g1; unpack8(*(const u32x4*)(SGA + o), g0, g1);
                        *(u32x4*)(MG + o) = pack8(g0 * acc[ai][bj][m][0], g1 * acc[ai][bj][m][1]);
                    }
                }
        } else if (HAS(T_BS)) {
            const bf16_t* SGS = (const bf16_t*)(ws + WS_SGS); bf16_t* MG = (bf16_t*)(ws + WS_MG);
#pragma unroll
            for (int ai = 0; ai < 2; ++ai)
#pragma unroll
                for (int m = 0; m < 4; ++m) {
                    const int row = rowb + ai * 128 + m * 16;
#pragma unroll
                    for (int bj = 0; bj < 2; ++bj) {
                        const size_t o = (size_t)row * 1024 + colb + bj * 128; f32x4 g0, g1, a0, a1; unpack8(*(const u32x4*)(SGS + o), g0, g1); unpack8(*(const u32x4*)(MG + o), a0, a1);
                        *(u32x4*)(MG + o) = pack8(a0 + g0 * acc[ai][bj][m][0], a1 + g1 * acc[ai][bj][m][1]);
                    }
                }
        } else if (HAS(T_PP)) {
            bf16_t* PP = (bf16_t*)(ws + WS_PP);
#pragma unroll
            for (int ai = 0; ai < 2; ++ai)
#pragma unroll
                for (int m = 0; m < 4; ++m) {
                    const int row = rowb + ai * 128 + m * 16;
#pragma unroll
                    for (int bj = 0; bj < 2; ++bj) *(u32x4*)(PP + (size_t)row * 1024 + colb + bj * 128) = pack8(acc[ai][bj][m][0], acc[ai][bj][m][1]);
                }
        } else if (HAS(T_OUT)) {
            float* T = (float*)(ws + WS_T);
#pragma unroll
            for (int ai = 0; ai < 2; ++ai)
#pragma unroll
                for (int m = 0; m < 4; ++m) {
                    const int row = rowb + ai * 128 + m * 16; float s = 0.f;
#pragma unroll
                    for (int bj = 0; bj < 2; ++bj) {
                        const f32x4 v0 = acc[ai][bj][m][0], v1 = acc[ai][bj][m][1]; float* p = T + (size_t)row * 1024 + colb + bj * 128; *(f32x4*)p = v0; *(f32x4*)(p + 4) = v1;
                        s += (v0[0] * v0[0] + v0[1] * v0[1]) + (v0[2] * v0[2] + v0[3] * v0[3]) + (v1[0] * v1[0] + v1[1] * v1[1]) + (v1[2] * v1[2] + v1[3] * v1[3]);
                    }
                    s += __shfl_xor(s, 16); s += __shfl_xor(s, 32);
                    if (fq == 0) atomicAdd(ssq + row, s);
                }
        } else if (HAS(T_GU)) {
            bf16_t* H = (bf16_t*)(ws + WS_H);
#pragma unroll
            for (int ai = 0; ai < 2; ++ai)
#pragma unroll
                for (int m = 0; m < 4; ++m) {
                    const int row = rowb + ai * 128 + m * 16; const float rs = RS[row];
                    const f32x4 g0 = acc[ai][0][m][0] * rs, g1 = acc[ai][0][m][1] * rs, u0 = acc[ai][1][m][0] * rs, u1 = acc[ai][1][m][1] * rs;
                    *(u32x4*)(H + (size_t)row * DFF + pn * 128 + wc * 32 + 8 * fq) = pack8(g0 * sigm4(g0) * u0, g1 * sigm4(g1) * u1);
                }
        } else if (HAS(T_PG)) {
            float* T = (float*)(ws + WS_T); const bf16_t* PP = (const bf16_t*)(ws + WS_PP);
#pragma unroll
            for (int ai = 0; ai < 2; ++ai)
#pragma unroll
                for (int m = 0; m < 4; ++m) {
                    const int row = rowb + ai * 128 + m * 16; const float rs = RS[row]; float s = 0.f;
#pragma unroll
                    for (int bj = 0; bj < 2; ++bj) {
                        const size_t o = (size_t)row * 1024 + colb + bj * 128; f32x4 p0, p1; unpack8(*(const u32x4*)(PP + o), p0, p1);
                        const f32x4 v0 = sigm4(acc[ai][bj][m][0] * rs) * p0, v1 = sigm4(acc[ai][bj][m][1] * rs) * p1;
                        *(f32x4*)(T + o) = v0; *(f32x4*)(T + o + 4) = v1;
                        s += (v0[0] * v0[0] + v0[1] * v0[1]) + (v0[2] * v0[2] + v0[3] * v0[3]) + (v1[0] * v1[0] + v1[1] * v1[1]) + (v1[2] * v1[2] + v1[3] * v1[3]);
                    }
                    s += __shfl_xor(s, 16); s += __shfl_xor(s, 32);
                    if (fq == 0) atomicAdd(ssq + row, s);
                }
        }
#undef HAS
    }
};

template <class EpiT>
__device__ __forceinline__ void gemm_phase(LAS unsigned char* lds, const Sched& S, const EpiT& E) {
    int tid_ = threadIdx.x; asm volatile("" : "+v"(tid_));
    const int tid = tid_, wid = __builtin_amdgcn_readfirstlane(tid >> 6), lane = tid & 63, wr = wid >> 2, wc = wid & 3, fr = lane & 15, fq = lane >> 4;
    int sR[2], sC[2], sRb[2];
#pragma unroll
    for (int i = 0; i < 2; ++i) { int R, C; stage_rc(tid * 16 + i * 8192, R, C); sR[i] = R; sC[i] = C; sRb[i] = (R & ~31) + perm32(R & 31); }
    const size_t kstep = (size_t)(BK * 2);
    const unsigned ldsw = (unsigned)wid * 1024u;
    const int aoff = lds_byte(wr * 64 + fr, fq * 8), boff = lds_byte(wc * 32 + fr, fq * 8);
#define PG8_SA(b, h) (((b) * 2 + (h)) * HTB)
#define PG8_SB(b, h) ((4 + (b) * 2 + (h)) * HTB)
#define PG8_STAGE(bufoff, gbase, voff) do { _Pragma("unroll") for (int _i = 0; _i < 2; ++_i) \
        __builtin_amdgcn_global_load_lds((const unsigned*)((const char*)(gbase) + (voff)[_i]), (LAS unsigned*)(lds + (bufoff) + ldsw + _i * 8192), 16, 0, 0); } while (0)
#define PG8_LDA(dst, b, h) do { _Pragma("unroll") for (int m = 0; m < 4; ++m) _Pragma("unroll") for (int k = 0; k < 2; ++k) dst[m][k] = *(const LAS bf16x8*)(lds + PG8_SA(b, h) + aoff + m * 2048 + k * 1024); } while (0)
#define PG8_LDB(dst, b, h) do { _Pragma("unroll") for (int n = 0; n < 2; ++n) _Pragma("unroll") for (int k = 0; k < 2; ++k) dst[n][k] = *(const LAS bf16x8*)(lds + PG8_SB(b, h) + boff + n * 2048 + k * 1024); } while (0)
#define PG8_MMA(ai, bj, At, Bt) do { __builtin_amdgcn_s_setprio(1); _Pragma("unroll") for (int m = 0; m < 4; ++m) _Pragma("unroll") for (int n = 0; n < 2; ++n) _Pragma("unroll") for (int k = 0; k < 2; ++k) \
        acc[ai][bj][m][n] = __builtin_amdgcn_mfma_f32_16x16x32_bf16(Bt[n][k], At[m][k], acc[ai][bj][m][n], 0, 0, 0); __builtin_amdgcn_s_setprio(0); } while (0)
#define PG8_WAIT_V(n) asm volatile("s_waitcnt vmcnt(" #n ")" ::: "memory")
#define PG8_WAIT_L(n) asm volatile("s_waitcnt lgkmcnt(" #n ")" ::: "memory")
#define PG8_BAR __builtin_amdgcn_s_barrier()
#define PG8_SCHED __builtin_amdgcn_sched_barrier(0)
    GUnit cur, nxt; int ui = 0;
    if (!S.next(0, cur)) return;
    f32x4 acc[2][2][4][2];
#pragma unroll
    for (int a = 0; a < 2; ++a)
#pragma unroll
        for (int b = 0; b < 2; ++b)
#pragma unroll
            for (int m = 0; m < 4; ++m)
#pragma unroll
                for (int n = 0; n < 2; ++n) acc[a][b][m][n] = (f32x4){0.f, 0.f, 0.f, 0.f};
    bf16x8 At[4][2], B0[2][2], B1[2][2];
    int K = cur.K;
    unsigned voffA[2], voffB[2];
#pragma unroll
    for (int i = 0; i < 2; ++i) { voffA[i] = (unsigned)(sR[i] * K + sC[i]) * 2u; voffB[i] = (unsigned)(sRb[i] * K + sC[i]) * 2u; }
    size_t hstep = (size_t)HALF * K * 2;
    const char* cA = cur.A; const char* cB = cur.Bt;
    PG8_STAGE(PG8_SB(0, 0), cB, voffB); PG8_STAGE(PG8_SB(0, 1), cB + hstep, voffB); PG8_STAGE(PG8_SA(0, 0), cA, voffA); PG8_STAGE(PG8_SA(0, 1), cA + hstep, voffA);
    if (wr == 1) PG8_BAR;
    PG8_WAIT_V(2); PG8_BAR;
    PG8_STAGE(PG8_SB(1, 0), cB + kstep, voffB); PG8_STAGE(PG8_SA(1, 0), cA + kstep, voffA); PG8_STAGE(PG8_SB(1, 1), cB + hstep + kstep, voffB);
    PG8_WAIT_V(6); PG8_BAR;
    for (;;) {
        const bool has_next = S.next(ui + 1, nxt);
        const int Kn = has_next ? nxt.K : K;
        const char* nA = has_next ? nxt.A : cA; const char* nB = has_next ? nxt.Bt : cB;
        unsigned voffAn[2], voffBn[2];
#pragma unroll
        for (int i = 0; i < 2; ++i) { voffAn[i] = (unsigned)(sR[i] * Kn + sC[i]) * 2u; voffBn[i] = (unsigned)(sRb[i] * Kn + sC[i]) * 2u; }
        const size_t hstepn = (size_t)HALF * Kn * 2;
        const int nt = K / BK;
        for (int t = 0; t < nt; t += 2) {
            const bool last = (t == nt - 2);
            const char* a1 = cA + (size_t)(t + 1) * kstep;
            const char* a2 = last ? nA : cA + (size_t)(t + 2) * kstep; const char* b2 = last ? nB : cB + (size_t)(t + 2) * kstep;
            const char* a3 = a2 + kstep; const char* b3 = b2 + kstep;
            unsigned vA2[2], vB2[2];
#pragma unroll
            for (int i = 0; i < 2; ++i) { vA2[i] = last ? voffAn[i] : voffA[i]; vB2[i] = last ? voffBn[i] : voffB[i]; }
            const size_t h2 = last ? hstepn : hstep;
            PG8_LDB(B0, 0, 0); PG8_LDB(B1, 0, 1); PG8_SCHED; PG8_LDA(At, 0, 0); PG8_STAGE(PG8_SA(1, 1), a1 + hstep, voffA);
            PG8_WAIT_V(8); PG8_WAIT_L(0); PG8_BAR; PG8_MMA(0, 0, At, B0); PG8_MMA(0, 1, At, B1); PG8_BAR; PG8_SCHED;
            PG8_LDA(At, 0, 1); PG8_STAGE(PG8_SB(0, 0), b2, vB2); PG8_STAGE(PG8_SB(0, 1), b2 + h2, vB2); PG8_STAGE(PG8_SA(0, 0), a2, vA2);
            PG8_WAIT_V(8); PG8_WAIT_L(0); PG8_BAR; PG8_MMA(1, 0, At, B0); PG8_MMA(1, 1, At, B1); PG8_BAR; PG8_SCHED;
            PG8_LDB(B0, 1, 0); PG8_LDB(B1, 1, 1); PG8_SCHED; PG8_LDA(At, 1, 0); PG8_STAGE(PG8_SA(0, 1), a2 + h2, vA2);
            PG8_WAIT_V(8); PG8_WAIT_L(0); PG8_BAR; PG8_MMA(0, 0, At, B0); PG8_MMA(0, 1, At, B1); PG8_BAR; PG8_SCHED;
            PG8_LDA(At, 1, 1); PG8_STAGE(PG8_SB(1, 0), b3, vB2); PG8_STAGE(PG8_SB(1, 1), b3 + h2, vB2); PG8_STAGE(PG8_SA(1, 0), a3, vA2);
            PG8_WAIT_V(8); PG8_WAIT_L(0); PG8_BAR; PG8_MMA(1, 0, At, B0); PG8_MMA(1, 1, At, B1); PG8_BAR; PG8_SCHED;
        }
        if (wr == 0) PG8_BAR;
        E(acc, cur, wr, wc, fr, fq);
        if (!has_next) break;
#pragma unroll
        for (int a = 0; a < 2; ++a)
#pragma unroll
            for (int b = 0; b < 2; ++b)
#pragma unroll
                for (int m = 0; m < 4; ++m)
#pragma unroll
                    for (int n = 0; n < 2; ++n) acc[a][b][m][n] = (f32x4){0.f, 0.f, 0.f, 0.f};
        cur = nxt; cA = nA; cB = nB; K = Kn; hstep = hstepn; ++ui;
#pragma unroll
        for (int i = 0; i < 2; ++i) { voffA[i] = voffAn[i]; voffB[i] = voffBn[i]; }
        if (wr == 1) PG8_BAR;
    }
    PG8_WAIT_V(0);
    PG8_BAR;
#undef PG8_SA
#undef PG8_SB
#undef PG8_STAGE
#undef PG8_LDA
#undef PG8_LDB
#undef PG8_MMA
#undef PG8_WAIT_V
#undef PG8_WAIT_L
#undef PG8_BAR
#undef PG8_SCHED
}
}

__device__ __forceinline__ void p0_transpose_item(const float* W, int K, int N, bf16_t* WT, int k0, int n0, int drow0, const float* gain, LAS float* scr, int lane) {
#pragma unroll 8
    for (int i = 0; i < 32; ++i) { const int kk = 2 * i + (lane >> 5); scr[kk * 33 + (lane & 31)] = W[(size_t)(k0 + kk) * N + n0 + (lane & 31)]; }
    asm volatile("s_waitcnt lgkmcnt(0)" ::: "memory");
    const int c = lane & 7;
    f32x4 g0 = (f32x4){1.f, 1.f, 1.f, 1.f}, g1 = g0;
    if (gain) { g0 = *(const f32x4*)(gain + k0 + 8 * c); g1 = *(const f32x4*)(gain + k0 + 8 * c + 4); }
#pragma unroll
    for (int j = 0; j < 4; ++j) { const int n = (lane >> 3) + 8 * j; const LAS float* s = scr + (8 * c) * 33 + n;
        u32x4 o; o.x = cvt_pk_bf16(s[0 * 33] * g0[0], s[1 * 33] * g0[1]); o.y = cvt_pk_bf16(s[2 * 33] * g0[2], s[3 * 33] * g0[3]); o.z = cvt_pk_bf16(s[4 * 33] * g1[0], s[5 * 33] * g1[1]); o.w = cvt_pk_bf16(s[6 * 33] * g1[2], s[7 * 33] * g1[3]);
        *(u32x4*)(WT + (size_t)(drow0 + n) * K + k0 + 8 * c) = o; }
    asm volatile("s_waitcnt lgkmcnt(0)" ::: "memory");
}
__device__ __forceinline__ void sincos_rr(float x, float& s, float& c) {
    const float kf = rintf(x * 0.6366197723675814f); const int k = (int)kf;
    float r = fmaf(kf, -1.57079637050628662109375f, x); r = fmaf(kf, 4.37113900018624283e-8f, r);
    const float r2 = r * r;
    const float sp = r + r * r2 * (-0.16666666641626524f + r2 * (0.0083333293858894632f + r2 * (-0.000198393348360966318f + r2 * 2.7183114939898219e-6f)));
    const float cp = 1.0f + r2 * (-0.499999997251031f + r2 * (0.0416666233237390f + r2 * (-0.00138867637746099f + r2 * 0.0000243904487962774f)));
    const int q = k & 3;
    s = (q == 0) ? sp : (q == 1) ? cp : (q == 2) ? -sp : -cp;
    c = (q == 0) ? cp : (q == 1) ? -sp : (q == 2) ? -cp : sp;
}
__device__ __forceinline__ void phase_prep(const Args& a, LAS unsigned char* lds, int gw, int NGW, int wave, int lane) {
    asm volatile("" : "+v"(lane));
    unsigned char* ws = a.ws;
    LAS float* scr = (LAS float*)(lds + wave * 16384);
    constexpr int I0 = 16 * 128, I1 = 8 * 16, I2 = 8 * 32, I3 = 8 * 32, I4 = 16 * 32, I5 = 16 * 88, I6 = 16 * 88, I7 = 44 * 32, I8 = 16 * 32, I9 = 4 * 32;
    constexpr int NIT = I0 + I1 + I2 + I3 + I4 + I5 + I6 + I7 + I8 + I9;
    for (int it = gw; it < NIT; it += NGW) {
        int r = it; const float* W; const float* gain = nullptr; bf16_t* WT; int K, N, mode = 0;
        if (r < I0) { W = a.in[10]; K = 1024; N = 4096; WT = (bf16_t*)(ws + WS_WIN); gain = a.in[8]; }
        else if ((r -= I0) < I1) { W = a.in[19]; K = 512; N = 512; WT = (bf16_t*)(ws + WS_WGLU); }
        else if ((r -= I1) < I2) { W = a.in[20]; K = 512; N = 1024; WT = (bf16_t*)(ws + WS_WBA); }
        else if ((r -= I2) < I3) { W = a.in[21]; K = 512; N = 1024; WT = (bf16_t*)(ws + WS_WBS); }
        else if ((r -= I3) < I4) { W = a.in[22]; K = 1024; N = 1024; WT = (bf16_t*)(ws + WS_WOUT); }
        else if ((r -= I4) < I5) { W = a.in[25]; K = 1024; N = 2816; WT = (bf16_t*)(ws + WS_WGU); gain = a.in[23]; mode = 1; }
        else if ((r -= I5) < I6) { W = a.in[26]; K = 1024; N = 2816; WT = (bf16_t*)(ws + WS_WGU); gain = a.in[23]; mode = 2; }
        else if ((r -= I6) < I7) { W = a.in[27]; K = 2816; N = 1024; WT = (bf16_t*)(ws + WS_WDN); }
        else if ((r -= I7) < I8) { W = a.in[30]; K = 1024; N = 1024; WT = (bf16_t*)(ws + WS_WPG); gain = a.in[28]; }
        else { r -= I8; W = a.in[31]; K = 256; N = 1024; WT = (bf16_t*)(ws + WS_WPP); }
        const int nblk = N / 32, kb = r / nblk, nb = r % nblk, k0 = 64 * kb, n0 = 32 * nb;
        const int drow0 = (mode == 0) ? n0 : ((n0 >> 7) * 256 + (mode == 2 ? 128 : 0) + (n0 & 127));
        p0_transpose_item(W, K, N, WT, k0, n0, drow0, gain, scr, lane);
    }
    bf16_t* XB = (bf16_t*)(ws + WS_XB); float* RS = (float*)(ws + WS_RS); bf16_t* PB = (bf16_t*)(ws + WS_PB);
    for (int row = gw; row < M; row += NGW) {
        const float* xr = row < MP ? a.in[0] + (size_t)row * D : a.in[1] + (size_t)(row - MP) * D;
        const float* pr = row < MP ? a.in[6] + (size_t)row * PLE : a.in[7] + (size_t)(row - MP) * PLE;
        float ss = 0.f;
#pragma unroll
        for (int j = 0; j < 4; ++j) { const f32x4 v = *(const f32x4*)(xr + 4 * (lane + 64 * j)); ss += (v[0] * v[0] + v[1] * v[1]) + (v[2] * v[2] + v[3] * v[3]);
            u32x2 w; w.x = cvt_pk_bf16(v[0], v[1]); w.y = cvt_pk_bf16(v[2], v[3]); *(u32x2*)(XB + (size_t)row * D + 4 * (lane + 64 * j)) = w; }
        ss = wave_sum(ss);
        if (lane == 0) RS[row] = 1.0f / sqrtf(ss * (1.0f / D) + EPS);
        { const f32x4 v = *(const f32x4*)(pr + 4 * lane); u32x2 w; w.x = cvt_pk_bf16(v[0], v[1]); w.y = cvt_pk_bf16(v[2], v[3]); *(u32x2*)(PB + (size_t)row * PLE + 4 * lane) = w; }
    }
    const int gt = gw * 64 + lane;
    if (gt < 2048) {
        const int g = gt >> 6;
        const float dt = expf(a.in[13][g]); const float are = a.in[11][gt], aim = a.in[12][gt];
        const float mag = expf(are * dt); float sn, cs; sincos_rr(aim * dt, sn, cs);
        const float lre = mag * cs, lim = mag * sn;
        const float den = are * are + aim * aim, nr = lre - 1.0f, ni = lim;
        const float fre = (nr * are + ni * aim) / den, fim = (ni * are - nr * aim) / den;
        float* LB = (float*)(ws + WS_LB); float* LB64 = (float*)(ws + WS_LB64); float* BB = (float*)(ws + WS_BB);
        LB[gt] = lre; LB[2048 + gt] = lim;
        float pr_ = lre, pi_ = lim;
#pragma unroll
        for (int i = 0; i < 6; ++i) { const float nr2 = pr_ * pr_ - pi_ * pi_, ni2 = 2.0f * pr_ * pi_; pr_ = nr2; pi_ = ni2; }
        LB64[gt] = pr_; LB64[2048 + gt] = pi_;
        const float* bre = a.in[14] + (size_t)gt * 16; const float* bim = a.in[15] + (size_t)gt * 16;
#pragma unroll
        for (int c = 0; c < 16; ++c) { const float br = bre[c], bi = bim[c]; BB[(size_t)gt * 16 + c] = fre * br - fim * bi; BB[32768 + (size_t)gt * 16 + c] = fre * bi + fim * br; }
    }
}

__device__ __forceinline__ void attn_item(int item, const Args& a, int lane) {
    asm volatile("" : "+v"(lane));
    float* out = a.out; unsigned char* ws = a.ws;
    const bool samp = item >= 4096;
    int b, h, qb, m0, P0;
    if (!samp) { b = item >> 9; h = (item >> 6) & 7; qb = item & 63; m0 = b * 2048 + qb * 32; P0 = qb * 32; }
    else { const int it = item - 4096; b = it >> 4; h = (it >> 1) & 7; qb = it & 1; m0 = MP + b * 64 + qb * 32; P0 = 4096 + qb * 32; }
    const int q = lane & 31, hi = lane >> 5;
    const bf16_t* Qp = (const bf16_t*)(ws + WS_Q) + (size_t)(m0 + q) * 512 + h * 64 + 8 * hi;
    bf16x8 qf[4];
#pragma unroll
    for (int ds = 0; ds < 4; ++ds) qf[ds] = *(const bf16x8*)(Qp + 16 * ds);
    f32x16 o0, o1;
#pragma unroll
    for (int r = 0; r < 16; ++r) { o0[r] = 0.f; o1[r] = 0.f; }
    float carry = 0.f;
    const int keyl = 16 * ((q >> 2) & 1) + 4 * (q >> 3) + (q & 3);
    const int Pq = P0 + q;
    for (int kt = P0 >> 5; kt >= 0; --kt) {
        const float* kp; const float* vp;
        if (!samp) { const size_t r0 = (size_t)(b * 2048 + kt * 32) * 512 + h * 64; kp = out + O_KP + r0; vp = out + O_VP + r0; }
        else if (kt < 128) { const size_t r0 = (size_t)(b * 4096 + kt * 32) * 512 + h * 64; kp = a.in[2] + r0; vp = a.in[3] + r0; }
        else { const size_t r0 = (size_t)(b * 64 + (kt - 128) * 32) * 512 + h * 64; kp = out + O_KS + r0; vp = out + O_VS + r0; }
        const float* kr = kp + (size_t)keyl * 512 + 8 * hi;
        f32x4 kx[8];
#pragma unroll
        for (int ds = 0; ds < 4; ++ds) { kx[2 * ds] = *(const f32x4*)(kr + 16 * ds); kx[2 * ds + 1] = *(const f32x4*)(kr + 16 * ds + 4); }
        float vx[2][2][8];
#pragma unroll
        for (int dh = 0; dh < 2; ++dh)
#pragma unroll
            for (int s = 0; s < 2; ++s)
#pragma unroll
                for (int kk = 0; kk < 8; ++kk) vx[dh][s][kk] = vp[(size_t)(16 * hi + 8 * s + kk) * 512 + 32 * dh + q];
        f32x16 st;
#pragma unroll
        for (int r = 0; r < 16; ++r) st[r] = 0.f;
#pragma unroll
        for (int ds = 0; ds < 4; ++ds) { const bf16x8 kf = __builtin_bit_cast(bf16x8, pack8(kx[2 * ds], kx[2 * ds + 1])); st = __builtin_amdgcn_mfma_f32_32x32x16_bf16(kf, qf[ds], st, 0, 0, 0); }
        float lk[16], zz[16]; float run = 0.f;
        const int s0 = 32 * kt + 16 * hi;
#pragma unroll
        for (int r = 15; r >= 0; --r) {
            const float z = st[r] * 0.125f; const bool vis = (s0 + r) < Pq;
            const float sp = fmaxf(z, 0.f) + __logf(1.0f + __expf(-fabsf(z)));
            const float l = vis ? -sp : 0.f;
            zz[r] = vis ? (z + l + run) : -1e30f;
            lk[r] = l; run += l;
        }
        const float oth = __shfl_xor(run, 32);
        const float add = carry + (hi == 0 ? oth : 0.f);
        float w[16];
#pragma unroll
        for (int r = 0; r < 16; ++r) w[r] = __expf(zz[r] + add);
        carry += run + oth;
        u32x4 wb0, wb1;
        wb0.x = cvt_pk_bf16(w[0], w[1]); wb0.y = cvt_pk_bf16(w[2], w[3]); wb0.z = cvt_pk_bf16(w[4], w[5]); wb0.w = cvt_pk_bf16(w[6], w[7]);
        wb1.x = cvt_pk_bf16(w[8], w[9]); wb1.y = cvt_pk_bf16(w[10], w[11]); wb1.z = cvt_pk_bf16(w[12], w[13]); wb1.w = cvt_pk_bf16(w[14], w[15]);
        const bf16x8 wf0 = __builtin_bit_cast(bf16x8, wb0), wf1 = __builtin_bit_cast(bf16x8, wb1);
#pragma unroll
        for (int dh = 0; dh < 2; ++dh) {
            u32x4 v0, v1;
            v0.x = cvt_pk_bf16(vx[dh][0][0], vx[dh][0][1]); v0.y = cvt_pk_bf16(vx[dh][0][2], vx[dh][0][3]); v0.z = cvt_pk_bf16(vx[dh][0][4], vx[dh][0][5]); v0.w = cvt_pk_bf16(vx[dh][0][6], vx[dh][0][7]);
            v1.x = cvt_pk_bf16(vx[dh][1][0], vx[dh][1][1]); v1.y = cvt_pk_bf16(vx[dh][1][2], vx[dh][1][3]); v1.z = cvt_pk_bf16(vx[dh][1][4], vx[dh][1][5]); v1.w = cvt_pk_bf16(vx[dh][1][6], vx[dh][1][7]);
            if (dh == 0) { o0 = __builtin_amdgcn_mfma_f32_32x32x16_bf16(__builtin_bit_cast(bf16x8, v0), wf0, o0, 0, 0, 0); o0 = __builtin_amdgcn_mfma_f32_32x32x16_bf16(__builtin_bit_cast(bf16x8, v1), wf1, o0, 0, 0, 0); }
            else { o1 = __builtin_amdgcn_mfma_f32_32x32x16_bf16(__builtin_bit_cast(bf16x8, v0), wf0, o1, 0, 0, 0); o1 = __builtin_amdgcn_mfma_f32_32x32x16_bf16(__builtin_bit_cast(bf16x8, v1), wf1, o1, 0, 0, 0); }
        }
        if (__all(carry < -104.0f)) break;
    }
    bf16_t* Op = (bf16_t*)(ws + WS_OA) + (size_t)(m0 + q) * 512 + h * 64;
#pragma unroll
    for (int j = 0; j < 4; ++j) {
        u32x2 w0, w1; w0.x = cvt_pk_bf16(o0[4 * j], o0[4 * j + 1]); w0.y = cvt_pk_bf16(o0[4 * j + 2], o0[4 * j + 3]); w1.x = cvt_pk_bf16(o1[4 * j], o1[4 * j + 1]); w1.y = cvt_pk_bf16(o1[4 * j + 2], o1[4 * j + 3]);
        *(u32x2*)(Op + 8 * j + 4 * hi) = w0; *(u32x2*)(Op + 32 + 8 * j + 4 * hi) = w1;
    }
}

template <bool PASS2>
__device__ __forceinline__ void ssm_item(int item, const Args& a, LAS unsigned char* wl, int lane) {
    asm volatile("" : "+v"(lane));
    unsigned char* ws = a.ws; float* out = a.out;
    int b, chunk, g, row0; bool samp = false;
    if (!PASS2) { b = item / 992; const int rem = item - b * 992; chunk = rem >> 5; g = rem & 31; row0 = b * 2048 + chunk * 64; }
    else if (item < 8192) { b = item >> 10; chunk = (item >> 5) & 31; g = item & 31; row0 = b * 2048 + chunk * 64; }
    else { const int it = item - 8192; b = it >> 5; g = it & 31; chunk = 0; row0 = MP + b * 64; samp = true; }
    const int p = lane, gp = g * 64 + p;
    const float* LB = (const float*)(ws + WS_LB); const float* BB = (const float*)(ws + WS_BB);
    const float lre = LB[gp], lim = LB[2048 + gp];
    float bbr[16], bbi[16];
#pragma unroll
    for (int c4 = 0; c4 < 4; ++c4) { const f32x4 x = *(const f32x4*)(BB + (size_t)gp * 16 + 4 * c4), y = *(const f32x4*)(BB + 32768 + (size_t)gp * 16 + 4 * c4);
#pragma unroll
        for (int e = 0; e < 4; ++e) { bbr[4 * c4 + e] = x[e]; bbi[4 * c4 + e] = y[e]; } }
    LAS float* ubuf = (LAS float*)wl;
    LAS bf16_t* sbuf = (LAS bf16_t*)(wl + 4096);
    const float* U = (const float*)(ws + WS_U);
#pragma unroll
    for (int i = 0; i < 4; ++i) { const int t = (lane >> 2) + 16 * i; *(LAS f32x4*)(ubuf + t * 16 + (lane & 3) * 4) = *(const f32x4*)(U + (size_t)(row0 + t) * 512 + g * 16 + (lane & 3) * 4); }
    float sre = 0.f, sim = 0.f;
    bf16x8 cf[4]; float dv = 0.f;
    if (PASS2) {
        if (samp) { sre = a.in[4][(size_t)(b * 32 + g) * 64 + p]; sim = a.in[5][(size_t)(b * 32 + g) * 64 + p]; }
        else {
            const float* LB64 = (const float*)(ws + WS_LB64); const float l6r = LB64[gp], l6i = LB64[2048 + gp];
            const float* E = (const float*)(ws + WS_E) + (size_t)b * 32 * 4096 + gp;
            for (int j = 0; j < chunk; ++j) { const float er = E[(size_t)j * 4096], ei = E[(size_t)j * 4096 + 2048]; const float nr = l6r * sre - l6i * sim + er, ni = l6r * sim + l6i * sre + ei; sre = nr; sim = ni; }
        }
        const int n = lane & 15, kg = lane >> 4;
#pragma unroll
        for (int ks = 0; ks < 4; ++ks) {
            const float* src = (ks < 2 ? a.in[16] : a.in[17]) + (size_t)(g * 16 + n) * 64 + (32 * (ks & 1) + 8 * kg);
            f32x4 x0 = *(const f32x4*)src, x1 = *(const f32x4*)(src + 4); if (ks >= 2) { x0 = -x0; x1 = -x1; }
            cf[ks] = __builtin_bit_cast(bf16x8, pack8(x0, x1));
        }
        dv = a.in[18][g * 16 + n];
    }
    asm volatile("s_waitcnt lgkmcnt(0)" ::: "memory");
    for (int tb = 0; tb < 4; ++tb) {
#pragma unroll
        for (int tt = 0; tt < 16; ++tt) {
            const LAS f32x4* up = (const LAS f32x4*)(ubuf + (tb * 16 + tt) * 16);
            const f32x4 u0 = up[0], u1 = up[1], u2 = up[2], u3 = up[3];
            float br = 0.f, bi = 0.f;
#pragma unroll
            for (int e = 0; e < 4; ++e) { br += bbr[e] * u0[e]; bi += bbi[e] * u0[e]; }
#pragma unroll
            for (int e = 0; e < 4; ++e) { br += bbr[4 + e] * u1[e]; bi += bbi[4 + e] * u1[e]; }
#pragma unroll
            for (int e = 0; e < 4; ++e) { br += bbr[8 + e] * u2[e]; bi += bbi[8 + e] * u2[e]; }
#pragma unroll
            for (int e = 0; e < 4; ++e) { br += bbr[12 + e] * u3[e]; bi += bbi[12 + e] * u3[e]; }
            const float nr = lre * sre - lim * sim + br, ni = lre * sim + lim * sre + bi; sre = nr; sim = ni;
            if (PASS2) { sbuf[tt * 136 + p] = (bf16_t)f2bf(sre); sbuf[tt * 136 + 64 + p] = (bf16_t)f2bf(sim); }
        }
        if (PASS2) {
            f32x4 y = (f32x4){0.f, 0.f, 0.f, 0.f};
            const int n = lane & 15, kg = lane >> 4;
#pragma unroll
            for (int ks = 0; ks < 4; ++ks) { const bf16x8 af = *(const LAS bf16x8*)(sbuf + n * 136 + 32 * ks + 8 * kg); y = __builtin_amdgcn_mfma_f32_16x16x32_bf16(af, cf[ks], y, 0, 0, 0); }
            bf16_t* YS = (bf16_t*)(ws + WS_YS);
#pragma unroll
            for (int r = 0; r < 4; ++r) {
                const int t = tb * 16 + 4 * kg + r; const float yv = y[r] + dv * ubuf[t * 16 + n];
                const float ge = yv * sigm(1.5957691216057308f * (yv + 0.044715f * yv * yv * yv));
                YS[(size_t)(row0 + t) * 512 + g * 16 + n] = (bf16_t)f2bf(ge);
            }
        }
    }
    if (!PASS2) { float* E = (float*)(ws + WS_E) + ((size_t)b * 32 + chunk) * 4096 + gp; E[0] = sre; E[2048] = sim; }
    else if (samp) { out[O_SRS + (size_t)(b * 32 + g) * 64 + p] = sre; out[O_SIS + (size_t)(b * 32 + g) * 64 + p] = sim; }
    else if (chunk == 31) { out[O_SRP + (size_t)(b * 32 + g) * 64 + p] = sre; out[O_SIP + (size_t)(b * 32 + g) * 64 + p] = sim; }
    asm volatile("s_waitcnt lgkmcnt(0)" ::: "memory");
}

__device__ __forceinline__ void row_pass(int mode, const Args& a, int gw, int NGW, int lane) {
    asm volatile("" : "+v"(lane));
    unsigned char* ws = a.ws; float* Y = a.out + O_Y;
    const float* T = (const float*)(ws + WS_T);
    const float* ssq = (const float*)(ws + (mode == 0 ? WS_SSQ1 : mode == 1 ? WS_SSQ2 : WS_SSQ3));
    const float* gain = a.in[mode == 0 ? 9 : mode == 1 ? 24 : 29];
    bf16_t* XB = (bf16_t*)(ws + WS_XB); float* RS = (float*)(ws + WS_RS);
    f32x4 gv[4];
#pragma unroll
    for (int j = 0; j < 4; ++j) gv[j] = *(const f32x4*)(gain + 4 * (lane + 64 * j));
    for (int row = gw; row < M; row += NGW) {
        const float* xr = (mode == 0) ? (row < MP ? a.in[0] + (size_t)row * D : a.in[1] + (size_t)(row - MP) * D) : Y + (size_t)row * D;
        const float rs = 1.0f / sqrtf(ssq[row] * (1.0f / D) + EPS);
        float ss = 0.f;
#pragma unroll
        for (int j = 0; j < 4; ++j) {
            const int c = 4 * (lane + 64 * j);
            const f32x4 x = *(const f32x4*)(xr + c), t = *(const f32x4*)(T + (size_t)row * D + c);
            const f32x4 v = x + t * gv[j] * rs;
            *(f32x4*)(Y + (size_t)row * D + c) = v;
            if (mode < 2) { ss += (v[0] * v[0] + v[1] * v[1]) + (v[2] * v[2] + v[3] * v[3]); u32x2 w; w.x = cvt_pk_bf16(v[0], v[1]); w.y = cvt_pk_bf16(v[2], v[3]); *(u32x2*)(XB + (size_t)row * D + c) = w; }
        }
        if (mode < 2) { ss = wave_sum(ss); if (lane == 0) RS[row] = 1.0f / sqrtf(ss * (1.0f / D) + EPS); }
    }
}

__global__ void __launch_bounds__(512, 2) fwd_kernel(Args a) {
    extern __shared__ __attribute__((aligned(16))) unsigned char lds_raw[];
    LAS unsigned char* lds = (LAS unsigned char*)lds_raw;
    cg::grid_group grid = cg::this_grid();
    const int tid = threadIdx.x, lane = tid & 63, wave = __builtin_amdgcn_readfirstlane(tid >> 6);
    const int G = gridDim.x, gw = blockIdx.x * 8 + wave, NGW = G * 8;
    unsigned char* ws = a.ws;
#define GEMM1(Ap, Bp, Kv, nNv, Tv, SSQ) do { pg8::Sched S; S.nd = 1; S.G = G; S.c = blockIdx.x; S.d0 = pg8::GDesc{(const bf16_t*)(ws + (Ap)), (const bf16_t*)(ws + (Bp)), (Kv), (nNv), (Tv)}; S.d1 = S.d0; S.d2 = S.d0; \
        pg8::Epi<(1 << (Tv))> E; E.out = a.out; E.ws = ws; E.ssq = (float*)(ws + (SSQ)); pg8::gemm_phase(lds, S, E); } while (0)
    phase_prep(a, lds, gw, NGW, wave, lane);
    grid.sync();
    GEMM1(WS_XB, WS_WIN, 1024, 16, pg8::T_IN, WS_SSQ1);
    grid.sync();
    for (int it = gw; it < 4352 + 7936; it += NGW) { if (it < 4352) attn_item(it, a, lane); else ssm_item<false>(it - 4352, a, lds + wave * 16384, lane); }
    grid.sync();
    for (int it = gw; it < 8704; it += NGW) ssm_item<true>(it, a, lds + wave * 16384, lane);
    grid.sync();
    { pg8::Sched S; S.nd = 3; S.G = G; S.c = blockIdx.x;
      S.d0 = pg8::GDesc{(const bf16_t*)(ws + WS_OA), (const bf16_t*)(ws + WS_WBA), 512, 4, pg8::T_BA};
      S.d1 = pg8::GDesc{(const bf16_t*)(ws + WS_YS), (const bf16_t*)(ws + WS_WGLU), 512, 2, pg8::T_GLU};
      S.d2 = pg8::GDesc{(const bf16_t*)(ws + WS_PB), (const bf16_t*)(ws + WS_WPP), 256, 4, pg8::T_PP};
      pg8::Epi<(1 << pg8::T_BA) | (1 << pg8::T_GLU) | (1 << pg8::T_PP)> E; E.out = a.out; E.ws = ws; E.ssq = nullptr; pg8::gemm_phase(lds, S, E); }
    grid.sync();
    GEMM1(WS_OS, WS_WBS, 512, 4, pg8::T_BS, WS_SSQ1);
    grid.sync();
    GEMM1(WS_MG, WS_WOUT, 1024, 4, pg8::T_OUT, WS_SSQ1);
    grid.sync();
    row_pass(0, a, gw, NGW, lane);
    grid.sync();
    GEMM1(WS_XB, WS_WGU, 1024, 22, pg8::T_GU, WS_SSQ1);
    grid.sync();
    GEMM1(WS_H, WS_WDN, 2816, 4, pg8::T_OUT, WS_SSQ2);
    grid.sync();
    row_pass(1, a, gw, NGW, lane);
    grid.sync();
    GEMM1(WS_XB, WS_WPG, 1024, 4, pg8::T_PG, WS_SSQ3);
    grid.sync();
    row_pass(2, a, gw, NGW, lane);
#undef GEMM1
}

extern "C" void kernel_launch(void* const* d_in, const int* in_sizes, int n_in, void* d_out, int out_size, void* d_ws, size_t ws_size, hipStream_t stream) {
    static int grid = 0;
    if (grid == 0) {
        if (n_in != 32 || ws_size < WS_END) { fprintf(stderr, "kernel_launch: unexpected n_in %d / ws_size %zu\n", n_in, ws_size); grid = -1; return; }
        int dev = 0, cus = 0, per_cu = 0;
        hipGetDevice(&dev); hipDeviceGetAttribute(&cus, hipDeviceAttributeMultiprocessorCount, dev);
        hipFuncSetAttribute((const void*)fwd_kernel, hipFuncAttributeMaxDynamicSharedMemorySize, LDS_BYTES);
        hipOccupancyMaxActiveBlocksPerMultiprocessor(&per_cu, (const void*)fwd_kernel, 512, LDS_BYTES);
        if (per_cu < 1) per_cu = 1;
        grid = cus * per_cu;
        (void)hipGetLastError();
    }
    if (grid < 0) return;
    hipMemsetAsync((char*)d_ws + WS_CTL, 0, CTL_BYTES, stream);
    Args a{};
    for (int i = 0; i < 32; ++i) a.in[i] = (const float*)d_in[i];
    a.out = (float*)d_out; a.ws = (unsigned char*)d_ws;
    void* args[] = {&a};
    hipError_t e = hipLaunchCooperativeKernel((const void*)fwd_kernel, dim3(grid), dim3(512), args, LDS_BYTES, stream);
    if (e != hipSuccess) fprintf(stderr, "cooperative launch failed: %s (grid %d)\n", hipGetErrorString(e), grid);
}
```

```cpp
#include <hip/hip_runtime.h>
#include <hip/hip_cooperative_groups.h>
#include <cstdio>
#include <cstdint>
namespace cg = cooperative_groups;

#define LAS __attribute__((address_space(3)))
typedef unsigned short bf16_t;
typedef short bf16x8 __attribute__((ext_vector_type(8)));
typedef float f32x4 __attribute__((ext_vector_type(4)));
typedef float f32x16 __attribute__((ext_vector_type(16)));
typedef unsigned u32x4 __attribute__((ext_vector_type(4)));
typedef unsigned u32x2 __attribute__((ext_vector_type(2)));

constexpr int MP = 16384, MS = 1024, M = MP + MS, NM = M / 256;
constexpr int D = 1024, DFF = 2816, SBW = 512, PLE = 256;
constexpr float EPS = 1e-6f;
constexpr size_t O_Y = 0, O_KP = 17825792, O_VP = 26214400, O_SRP = 34603008, O_SIP = 34619392, O_KS = 34635776, O_VS = 35160064, O_SRS = 35684352, O_SIS = 35717120;
constexpr size_t MiB = 1u << 20;
constexpr size_t WS_CTL = 0, CTL_BYTES = 1 * MiB;
constexpr size_t WS_BAR = 16 * 1024;
constexpr size_t WS_SSQ1 = 64 * 1024, WS_SSQ2 = 192 * 1024, WS_SSQ3 = 320 * 1024;
constexpr size_t WS_WIN = 2 * MiB, WS_WGLU = 10 * MiB, WS_WBA = 11 * MiB, WS_WBS = 12 * MiB, WS_WOUT = 13 * MiB, WS_WGU = 15 * MiB, WS_WDN = 26 * MiB, WS_WPG = 32 * MiB, WS_WPP = 34 * MiB;
constexpr size_t WS_LB = 35 * MiB, WS_LB64 = WS_LB + 16 * 1024, WS_BB = WS_LB + 64 * 1024, WS_RS = WS_LB + 512 * 1024;
constexpr size_t WS_E = 36 * MiB;
constexpr size_t WS_XB = 40 * MiB, WS_Q = 74 * MiB, WS_U = 91 * MiB, WS_SGA = 125 * MiB, WS_SGS = 159 * MiB, WS_OA = 193 * MiB, WS_YS = 210 * MiB, WS_OS = 227 * MiB, WS_MG = 244 * MiB;
constexpr size_t WS_T = 278 * MiB, WS_PP = 346 * MiB, WS_PB = 380 * MiB, WS_END = 389 * MiB;
constexpr size_t WS_H = 74 * MiB;
static_assert(WS_H + (size_t)M * DFF * 2 <= WS_OA, "H overlay");
constexpr int LDS_BYTES = 147456;

struct Args { const float* in[32]; float* out; unsigned char* ws; };

__device__ __forceinline__ unsigned cvt_pk_bf16(float lo, float hi) { unsigned r; asm volatile("v_cvt_pk_bf16_f32 %0, %1, %2" : "=v"(r) : "v"(lo), "v"(hi)); return r; }
__device__ __forceinline__ unsigned f2bf(float f) { unsigned u = __builtin_bit_cast(unsigned, f); return (u + 0x7fffu + ((u >> 16) & 1u)) >> 16; }
__device__ __forceinline__ float bflo(unsigned w) { return __builtin_bit_cast(float, w << 16); }
__device__ __forceinline__ float bfhi(unsigned w) { return __builtin_bit_cast(float, w & 0xffff0000u); }
__device__ __forceinline__ u32x4 pack8(f32x4 a, f32x4 b) { u32x4 w; w.x = cvt_pk_bf16(a[0], a[1]); w.y = cvt_pk_bf16(a[2], a[3]); w.z = cvt_pk_bf16(b[0], b[1]); w.w = cvt_pk_bf16(b[2], b[3]); return w; }
__device__ __forceinline__ void unpack8(u32x4 w, f32x4& a, f32x4& b) { a = (f32x4){bflo(w.x), bfhi(w.x), bflo(w.y), bfhi(w.y)}; b = (f32x4){bflo(w.z), bfhi(w.z), bflo(w.w), bfhi(w.w)}; }
__device__ __forceinline__ float sigm(float x) { return __builtin_amdgcn_rcpf(1.0f + __expf(-x)); }
__device__ __forceinline__ f32x4 sigm4(f32x4 v) { return (f32x4){sigm(v[0]), sigm(v[1]), sigm(v[2]), sigm(v[3])}; }
__device__ __forceinline__ float wave_sum(float v) {
#pragma unroll
    for (int o = 1; o < 64; o <<= 1) v += __shfl_xor(v, o);
    return v;
}

namespace pg8 {
constexpr int BM = 256, BK = 64, HALF = 128, HTB = HALF * BK * 2, STAGE_BYTES = 8 * HTB, NXCD = 8, WGM = 8;
__device__ __forceinline__ int lds_byte(int r, int c) { const int st = (r >> 4) * 2 + (c >> 5), rr = r & 15, cc = c & 31, ob = rr * 64 + cc * 2; return st * 1024 + (ob ^ (((ob >> 9) & 1) << 5)); }
__device__ __forceinline__ void stage_rc(int b, int& R, int& C) { const int st = b / 1024, sb = b % 1024, swz = sb ^ (((sb >> 9) & 1) << 5); R = (st >> 1) * 16 + swz / 64; C = (st & 1) * 32 + (swz % 64) / 2; }
__device__ __forceinline__ int perm32(int rho) { const int n = rho >> 4, i = rho & 15; return 8 * (i >> 2) + 4 * n + (i & 3); }

enum { T_IN = 0, T_GLU, T_BA, T_PP, T_BS, T_OUT, T_GU, T_PG };
struct GUnit { const char* A; const char* Bt; int K, pm, pn, type; };
struct GDesc { const bf16_t* A; const bf16_t* Bt; int K, nN, type; };

__device__ __forceinline__ void map_unit(int L, const GDesc& d, GUnit& u) {
    const int nN = d.nN, nwg = NM * nN;
    int wgid = L; { const int q = nwg / NXCD, r = nwg % NXCD, xcd = wgid % NXCD, off = wgid / NXCD; wgid = (xcd < r ? xcd * (q + 1) : r * (q + 1) + (xcd - r) * q) + off; }
    const int nig = WGM * nN, gid = wgid / nig, fm = gid * WGM, gsz = (NM - fm) < WGM ? (NM - fm) : WGM;
    u.pm = fm + ((wgid % nig) % gsz); u.pn = (wgid % nig) / gsz; u.K = d.K; u.type = d.type;
    u.A = (const char*)d.A + (size_t)u.pm * 512 * d.K; u.Bt = (const char*)d.Bt + (size_t)u.pn * 512 * d.K;
}
struct Sched {
    GDesc d0, d1, d2; int nd, G, c;
    __device__ __forceinline__ bool next(int i, GUnit& u) const {
        long L = (long)i * G + c;
        const int n0 = NM * d0.nN; if (L < n0) { map_unit((int)L, d0, u); return true; } L -= n0;
        if (nd < 2) return false;
        const int n1 = NM * d1.nN; if (L < n1) { map_unit((int)L, d1, u); return true; } L -= n1;
        if (nd < 3) return false;
        const int n2 = NM * d2.nN; if (L < n2) { map_unit((int)L, d2, u); return true; }
        return false;
    }
};

template <int TMASK> struct Epi {
    float* out; unsigned char* ws; float* ssq;
    __device__ __forceinline__ void operator()(const f32x4 (&acc)[2][2][4][2], const GUnit& u, int wr, int wc, int fr, int fq) const {
        const int rowb = u.pm * 256 + wr * 64 + fr, colb = u.pn * 256 + wc * 32 + 8 * fq;
        const float* RS = (const float*)(ws + WS_RS);
        const int type = u.type, pn = u.pn;
#define HAS(t) (((TMASK >> (t)) & 1) && (TMASK == (1 << (t)) || type == (t)))
        if (HAS(T_IN)) {
            bf16_t* Qb = (bf16_t*)(ws + WS_Q); float* Ub = (float*)(ws + WS_U); bf16_t* SGA = (bf16_t*)(ws + WS_SGA); bf16_t* SGS = (bf16_t*)(ws + WS_SGS);
            const bool pr = u.pm < 64;
#pragma unroll
            for (int ai = 0; ai < 2; ++ai)
#pragma unroll
                for (int m = 0; m < 4; ++m) {
                    const int row = rowb + ai * 128 + m * 16; const float rs = RS[row];
                    float* kd = pr ? out + O_KP + (size_t)row * 512 : out + O_KS + (size_t)(row - MP) * 512;
                    float* vd = pr ? out + O_VP + (size_t)row * 512 : out + O_VS + (size_t)(row - MP) * 512;
#pragma unroll
                    for (int bj = 0; bj < 2; ++bj) {
                        const int col = colb + bj * 128; const f32x4 v0 = acc[ai][bj][m][0] * rs, v1 = acc[ai][bj][m][1] * rs;
                        if (pn < 2) *(u32x4*)(Qb + (size_t)row * 512 + col) = pack8(v0, v1);
                        else if (pn < 4) { float* p = kd + (col - 512); *(f32x4*)p = v0; *(f32x4*)(p + 4) = v1; }
                        else if (pn < 6) { float* p = vd + (col - 1024); *(f32x4*)p = v0; *(f32x4*)(p + 4) = v1; }
                        else if (pn < 8) { float* p = Ub + (size_t)row * 512 + (col - 1536); *(f32x4*)p = v0; *(f32x4*)(p + 4) = v1; }
                        else if (pn < 12) *(u32x4*)(SGA + (size_t)row * 1024 + (col - 2048)) = pack8(sigm4(v0), sigm4(v1));
                        else *(u32x4*)(SGS + (size_t)row * 1024 + (col - 3072)) = pack8(sigm4(v0), sigm4(v1));
                    }
                }
        } else if (HAS(T_GLU)) {
            const bf16_t* YS = (const bf16_t*)(ws + WS_YS); bf16_t* OS = (bf16_t*)(ws + WS_OS);
#pragma unroll
            for (int ai = 0; ai < 2; ++ai)
#pragma unroll
                for (int m = 0; m < 4; ++m) {
                    const int row = rowb + ai * 128 + m * 16;
#pragma unroll
                    for (int bj = 0; bj < 2; ++bj) {
                        const size_t o = (size_t)row * 512 + colb + bj * 128; f32x4 y0, y1; unpack8(*(const u32x4*)(YS + o), y0, y1);
                        *(u32x4*)(OS + o) = pack8(y0 * sigm4(acc[ai][bj][m][0]), y1 * sigm4(acc[ai][bj][m][1]));
                    }
                }
        } else if (HAS(T_BA)) {
            const bf16_t* SGA = (const bf16_t*)(ws + WS_SGA); bf16_t* MG = (bf16_t*)(ws + WS_MG);
#pragma unroll
            for (int ai = 0; ai < 2; ++ai)
#pragma unroll
                for (int m = 0; m < 4; ++m) {
                    const int row = rowb + ai * 128 + m * 16;
#pragma unroll
                    for (int bj = 0; bj < 2; ++bj) {
                        const size_t o = (size_t)row * 1024 + colb + bj * 128; f32x4 g0, g1; unpack8(*(const u32x4*)(SGA + o), g0, g1);
                        *(u32x4*)(MG + o) = pack8(g0 * acc[ai][bj][m][0], g1 * acc[ai][bj][m][1]);
                    }
                }
        } else if (HAS(T_BS)) {
            const bf16_t* SGS = (const bf16_t*)(ws + WS_SGS); bf16_t* MG = (bf16_t*)(ws + WS_MG);
#pragma unroll
            for (int ai = 0; ai < 2; ++ai)
#pragma unroll
                for (int m = 0; m < 4; ++m) {
                    const int row = rowb + ai * 128 + m * 16;
#pragma unroll
                    for (int bj = 0; bj < 2; ++bj) {
                        const size_t o = (size_t)row * 1024 + colb + bj * 128; f32x4 g0, g1, a0, a1; unpack8(*(const u32x4*)(SGS + o), g0, g1); unpack8(*(const u32x4*)(MG + o), a0, a1);
                        *(u32x4*)(MG + o) = pack8(a0 + g0 * acc[ai][bj][m][0], a1 + g1 * acc[ai][bj][m][1]);
                    }
                }
        } else if (HAS(T_PP)) {
            bf16_t* PP = (bf16_t*)(ws + WS_PP);
#pragma unroll
            for (int ai = 0; ai < 2; ++ai)
#pragma unroll
                for (int m = 0; m < 4; ++m) {
                    const int row = rowb + ai * 128 + m * 16;
#pragma unroll
                    for (int bj = 0; bj < 2; ++bj) *(u32x4*)(PP + (size_t)row * 1024 + colb + bj * 128) = pack8(acc[ai][bj][m][0], acc[ai][bj][m][1]);
                }
        } else if (HAS(T_OUT)) {
            float* T = (float*)(ws + WS_T);
#pragma unroll
            for (int ai = 0; ai < 2; ++ai)
#pragma unroll
                for (int m = 0; m < 4; ++m) {
                    const int row = rowb + ai * 128 + m * 16; float s = 0.f;
#pragma unroll
                    for (int bj = 0; bj < 2; ++bj) {
                        const f32x4 v0 = acc[ai][bj][m][0], v1 = acc[ai][bj][m][1]; float* p = T + (size_t)row * 1024 + colb + bj * 128; *(f32x4*)p = v0; *(f32x4*)(p + 4) = v1;
                        s += (v0[0] * v0[0] + v0[1] * v0[1]) + (v0[2] * v0[2] + v0[3] * v0[3]) + (v1[0] * v1[0] + v1[1] * v1[1]) + (v1[2] * v1[2] + v1[3] * v1[3]);
                    }
                    s += __shfl_xor(s, 16); s += __shfl_xor(s, 32);
                    if (fq == 0) atomicAdd(ssq + row, s);
                }
        } else if (HAS(T_GU)) {
            bf16_t* H = (bf16_t*)(ws + WS_H);
#pragma unroll
            for (int ai = 0; ai < 2; ++ai)
#pragma unroll
                for (int m = 0; m < 4; ++m) {
                    const int row = rowb + ai * 128 + m * 16; const float rs = RS[row];
                    const f32x4 g0 = acc[ai][0][m][0] * rs, g1 = acc[ai][0][m][1] * rs, u0 = acc[ai][1][m][0] * rs, u1 = acc[ai][1][m][1] * rs;
                    *(u32x4*)(H + (size_t)row * DFF + pn * 128 + wc * 32 + 8 * fq) = pack8(g0 * sigm4(g0) * u0, g1 * sigm4(g1) * u1);
                }
        } else if (HAS(T_PG)) {
            float* T = (float*)(ws + WS_T); const bf16_t* PP = (const bf16_t*)(ws + WS_PP);
#pragma unroll
            for (int ai = 0; ai < 2; ++ai)
#pragma unroll
                for (int m = 0; m < 4; ++m) {
                    const int row = rowb + ai * 128 + m * 16; const float rs = RS[row]; float s = 0.f;
#pragma unroll
                    for (int bj = 0; bj < 2; ++bj) {
                        const size_t o = (size_t)row * 1024 + colb + bj * 128; f32x4 p0, p1; unpack8(*(const u32x4*)(PP + o), p0, p1);
                        const f32x4 v0 = sigm4(acc[ai][bj][m][0] * rs) * p0, v1 = sigm4(acc[ai][bj][m][1] * rs) * p1;
                        *(f32x4*)(T + o) = v0; *(f32x4*)(T + o + 4) = v1;
                        s += (v0[0] * v0[0] + v0[1] * v0[1]) + (v0[2] * v0[2] + v0[3] * v0[3]) + (v1[0] * v1[0] + v1[1] * v1[1]) + (v1[2] * v1[2] + v1[3] * v1[3]);
                    }
                    s += __shfl_xor(s, 16); s += __shfl_xor(s, 32);
                    if (fq == 0) atomicAdd(ssq + row, s);
                }
        }
#undef HAS
    }
};

template <class EpiT>
__device__ __forceinline__ void gemm_phase(LAS unsigned char* lds, const Sched& S, const EpiT& E) {
    int tid_ = threadIdx.x; asm volatile("" : "+v"(tid_));
    const int tid = tid_, wid = __builtin_amdgcn_readfirstlane(tid >> 6), lane = tid & 63, wr = wid >> 2, wc = wid & 3, fr = lane & 15, fq = lane >> 4;
    int sR[2], sC[2], sRb[2];
#pragma unroll
    for (int i = 0; i < 2; ++i) { int R, C; stage_rc(tid * 16 + i * 8192, R, C); sR[i] = R; sC[i] = C; sRb[i] = (R & ~31) + perm32(R & 31); }
    const size_t kstep = (size_t)(BK * 2);
    const unsigned ldsw = (unsigned)wid * 1024u;
    const int aoff = lds_byte(wr * 64 + fr, fq * 8), boff = lds_byte(wc * 32 + fr, fq * 8);
#define PG8_SA(b, h) (((b) * 2 + (h)) * HTB)
#define PG8_SB(b, h) ((4 + (b) * 2 + (h)) * HTB)
#define PG8_STAGE(bufoff, gbase, voff) do { _Pragma("unroll") for (int _i = 0; _i < 2; ++_i) \
        __builtin_amdgcn_global_load_lds((const unsigned*)((const char*)(gbase) + (voff)[_i]), (LAS unsigned*)(lds + (bufoff) + ldsw + _i * 8192), 16, 0, 0); } while (0)
#define PG8_LDA(dst, b, h) do { _Pragma("unroll") for (int m = 0; m < 4; ++m) _Pragma("unroll") for (int k = 0; k < 2; ++k) dst[m][k] = *(const LAS bf16x8*)(lds + PG8_SA(b, h) + aoff + m * 2048 + k * 1024); } while (0)
#define PG8_LDB(dst, b, h) do { _Pragma("unroll") for (int n = 0; n < 2; ++n) _Pragma("unroll") for (int k = 0; k < 2; ++k) dst[n][k] = *(const LAS bf16x8*)(lds + PG8_SB(b, h) + boff + n * 2048 + k * 1024); } while (0)
#define PG8_MMA(ai, bj, At, Bt) do { __builtin_amdgcn_s_setprio(1); _Pragma("unroll") for (int m = 0; m < 4; ++m) _Pragma("unroll") for (int n = 0; n < 2; ++n) _Pragma("unroll") for (int k = 0; k < 2; ++k) \
        acc[ai][bj][m][n] = __builtin_amdgcn_mfma_f32_16x16x32_bf16(Bt[n][k], At[m][k], acc[ai][bj][m][n], 0, 0, 0); __builtin_amdgcn_s_setprio(0); } while (0)
#define PG8_WAIT_V(n) asm volatile("s_waitcnt vmcnt(" #n ")" ::: "memory")
#define PG8_WAIT_L(n) asm volatile("s_waitcnt lgkmcnt(" #n ")" ::: "memory")
#define PG8_BAR __builtin_amdgcn_s_barrier()
#define PG8_SCHED __builtin_amdgcn_sched_barrier(0)
    GUnit cur, nxt; int ui = 0;
    if (!S.next(0, cur)) return;
    f32x4 acc[2][2][4][2];
#pragma unroll
    for (int a = 0; a < 2; ++a)
#pragma unroll
        for (int b = 0; b < 2; ++b)
#pragma unroll
            for (int m = 0; m < 4; ++m)
#pragma unroll
                for (int n = 0; n < 2; ++n) acc[a][b][m][n] = (f32x4){0.f, 0.f, 0.f, 0.f};
    bf16x8 At[4][2], B0[2][2], B1[2][2];
    int K = cur.K;
    unsigned voffA[2], voffB[2];
#pragma unroll
    for (int i = 0; i < 2; ++i) { voffA[i] = (unsigned)(sR[i] * K + sC[i]) * 2u; voffB[i] = (unsigned)(sRb[i] * K + sC[i]) * 2u; }
    size_t hstep = (size_t)HALF * K * 2;
    const char* cA = cur.A; const char* cB = cur.Bt;
    PG8_STAGE(PG8_SB(0, 0), cB, voffB); PG8_STAGE(PG8_SB(0, 1), cB + hstep, voffB); PG8_STAGE(PG8_SA(0, 0), cA, voffA); PG8_STAGE(PG8_SA(0, 1), cA + hstep, voffA);
    if (wr == 1) PG8_BAR;
    PG8_WAIT_V(2); PG8_BAR;
    PG8_STAGE(PG8_SB(1, 0), cB + kstep, voffB); PG8_STAGE(PG8_SA(1, 0), cA + kstep, voffA); PG8_STAGE(PG8_SB(1, 1), cB + hstep + kstep, voffB);
    PG8_WAIT_V(6); PG8_BAR;
    for (;;) {
        const bool has_next = S.next(ui + 1, nxt);
        const int Kn = has_next ? nxt.K : K;
        const char* nA = has_next ? nxt.A : cA; const char* nB = has_next ? nxt.Bt : cB;
        unsigned voffAn[2], voffBn[2];
#pragma unroll
        for (int i = 0; i < 2; ++i) { voffAn[i] = (unsigned)(sR[i] * Kn + sC[i]) * 2u; voffBn[i] = (unsigned)(sRb[i] * Kn + sC[i]) * 2u; }
        const size_t hstepn = (size_t)HALF * Kn * 2;
        const int nt = K / BK;
        for (int t = 0; t < nt; t += 2) {
            const bool last = (t == nt - 2);
            const char* a1 = cA + (size_t)(t + 1) * kstep;
            const char* a2 = last ? nA : cA + (size_t)(t + 2) * kstep; const char* b2 = last ? nB : cB + (size_t)(t + 2) * kstep;
            const char* a3 = a2 + kstep; const char* b3 = b2 + kstep;
            unsigned vA2[2], vB2[2];
#pragma unroll
            for (int i = 0; i < 2; ++i) { vA2[i] = last ? voffAn[i] : voffA[i]; vB2[i] = last ? voffBn[i] : voffB[i]; }
            const size_t h2 = last ? hstepn : hstep;
            PG8_LDB(B0, 0, 0); PG8_LDB(B1, 0, 1); PG8_SCHED; PG8_LDA(At, 0, 0); PG8_STAGE(PG8_SA(1, 1), a1 + hstep, voffA);
            PG8_WAIT_V(8); PG8_WAIT_L(0); PG8_BAR; PG8_MMA(0, 0, At, B0); PG8_MMA(0, 1, At, B1); PG8_BAR; PG8_SCHED;
            PG8_LDA(At, 0, 1); PG8_STAGE(PG8_SB(0, 0), b2, vB2); PG8_STAGE(PG8_SB(0, 1), b2 + h2, vB2); PG8_STAGE(PG8_SA(0, 0), a2, vA2);
            PG8_WAIT_V(8); PG8_WAIT_L(0); PG8_BAR; PG8_MMA(1, 0, At, B0); PG8_MMA(1, 1, At, B1); PG8_BAR; PG8_SCHED;
            PG8_LDB(B0, 1, 0); PG8_LDB(B1, 1, 1); PG8_SCHED; PG8_LDA(At, 1, 0); PG8_STAGE(PG8_SA(0, 1), a2 + h2, vA2);
            PG8_WAIT_V(8); PG8_WAIT_L(0); PG8_BAR; PG8_MMA(0, 0, At, B0); PG8_MMA(0, 1, At, B1); PG8_BAR; PG8_SCHED;
            PG8_LDA(At, 1, 1); PG8_STAGE(PG8_SB(1, 0), b3, vB2); PG8_STAGE(PG8_SB(1, 1), b3 + h2, vB2); PG8_STAGE(PG8_SA(1, 0), a3, vA2);
            PG8_WAIT_V(8); PG8_WAIT_L(0); PG8_BAR; PG8_MMA(1, 0, At, B0); PG8_MMA(1, 1, At, B1); PG8_BAR; PG8_SCHED;
        }
        if (wr == 0) PG8_BAR;
        E(acc, cur, wr, wc, fr, fq);
        if (!has_next) break;
#pragma unroll
        for (int a = 0; a < 2; ++a)
#pragma unroll
            for (int b = 0; b < 2; ++b)
#pragma unroll
                for (int m = 0; m < 4; ++m)
#pragma unroll
                    for (int n = 0; n < 2; ++n) acc[a][b][m][n] = (f32x4){0.f, 0.f, 0.f, 0.f};
        cur = nxt; cA = nA; cB = nB; K = Kn; hstep = hstepn; ++ui;
#pragma unroll
        for (int i = 0; i < 2; ++i) { voffA[i] = voffAn[i]; voffB[i] = voffBn[i]; }
        if (wr == 1) PG8_BAR;
    }
    PG8_WAIT_V(0);
    PG8_BAR;
#undef PG8_SA
#undef PG8_SB
#undef PG8_STAGE
#undef PG8_LDA
#undef PG8_LDB
#undef PG8_MMA
#undef PG8_WAIT_V
#undef PG8_WAIT_L
#undef PG8_BAR
#undef PG8_SCHED
}
}

__device__ __forceinline__ void p0_transpose_item(const float* W, int K, int N, bf16_t* WT, int k0, int n0, int drow0, const float* gain, LAS float* scr, int lane) {
#pragma unroll 8
    for (int i = 0; i < 32; ++i) { const int kk = 2 * i + (lane >> 5); scr[kk * 33 + (lane & 31)] = W[(size_t)(k0 + kk) * N + n0 + (lane & 31)]; }
    asm volatile("s_waitcnt lgkmcnt(0)" ::: "memory");
    const int c = lane & 7;
    f32x4 g0 = (f32x4){1.f, 1.f, 1.f, 1.f}, g1 = g0;
    if (gain) { g0 = *(const f32x4*)(gain + k0 + 8 * c); g1 = *(const f32x4*)(gain + k0 + 8 * c + 4); }
#pragma unroll
    for (int j = 0; j < 4; ++j) { const int n = (lane >> 3) + 8 * j; const LAS float* s = scr + (8 * c) * 33 + n;
        u32x4 o; o.x = cvt_pk_bf16(s[0 * 33] * g0[0], s[1 * 33] * g0[1]); o.y = cvt_pk_bf16(s[2 * 33] * g0[2], s[3 * 33] * g0[3]); o.z = cvt_pk_bf16(s[4 * 33] * g1[0], s[5 * 33] * g1[1]); o.w = cvt_pk_bf16(s[6 * 33] * g1[2], s[7 * 33] * g1[3]);
        *(u32x4*)(WT + (size_t)(drow0 + n) * K + k0 + 8 * c) = o; }
    asm volatile("s_waitcnt lgkmcnt(0)" ::: "memory");
}
__device__ __forceinline__ void sincos_rr(float x, float& s, float& c) {
    const float kf = rintf(x * 0.6366197723675814f); const int k = (int)kf;
    float r = fmaf(kf, -1.57079637050628662109375f, x); r = fmaf(kf, 4.37113900018624283e-8f, r);
    const float r2 = r * r;
    const float sp = r + r * r2 * (-0.16666666641626524f + r2 * (0.0083333293858894632f + r2 * (-0.000198393348360966318f + r2 * 2.7183114939898219e-6f)));
    const float cp = 1.0f + r2 * (-0.499999997251031f + r2 * (0.0416666233237390f + r2 * (-0.00138867637746099f + r2 * 0.0000243904487962774f)));
    const int q = k & 3;
    s = (q == 0) ? sp : (q == 1) ? cp : (q == 2) ? -sp : -cp;
    c = (q == 0) ? cp : (q == 1) ? -sp : (q == 2) ? -cp : sp;
}
__device__ __forceinline__ void phase_prep(const Args& a, LAS unsigned char* lds, int gw, int NGW, int wave, int lane) {
    asm volatile("" : "+v"(lane));
    unsigned char* ws = a.ws;
    LAS float* scr = (LAS float*)(lds + wave * 16384);
    constexpr int I0 = 16 * 128, I1 = 8 * 16, I2 = 8 * 32, I3 = 8 * 32, I4 = 16 * 32, I5 = 16 * 88, I6 = 16 * 88, I7 = 44 * 32, I8 = 16 * 32, I9 = 4 * 32;
    constexpr int NIT = I0 + I1 + I2 + I3 + I4 + I5 + I6 + I7 + I8 + I9;
    for (int it = gw; it < NIT; it += NGW) {
        int r = it; const float* W; const float* gain = nullptr; bf16_t* WT; int K, N, mode = 0;
        if (r < I0) { W = a.in[10]; K = 1024; N = 4096; WT = (bf16_t*)(ws + WS_WIN); gain = a.in[8]; }
        else if ((r -= I0) < I1) { W = a.in[19]; K = 512; N = 512; WT = (bf16_t*)(ws + WS_WGLU); }
        else if ((r -= I1) < I2) { W = a.in[20]; K = 512; N = 1024; WT = (bf16_t*)(ws + WS_WBA); }
        else if ((r -= I2) < I3) { W = a.in[21]; K = 512; N = 1024; WT = (bf16_t*)(ws + WS_WBS); }
        else if ((r -= I3) < I4) { W = a.in[22]; K = 1024; N = 1024; WT = (bf16_t*)(ws + WS_WOUT); }
        else if ((r -= I4) < I5) { W = a.in[25]; K = 1024; N = 2816; WT = (bf16_t*)(ws + WS_WGU); gain = a.in[23]; mode = 1; }
        else if ((r -= I5) < I6) { W = a.in[26]; K = 1024; N = 2816; WT = (bf16_t*)(ws + WS_WGU); gain = a.in[23]; mode = 2; }
        else if ((r -= I6) < I7) { W = a.in[27]; K = 2816; N = 1024; WT = (bf16_t*)(ws + WS_WDN); }
        else if ((r -= I7) < I8) { W = a.in[30]; K = 1024; N = 1024; WT = (bf16_t*)(ws + WS_WPG); gain = a.in[28]; }
        else { r -= I8; W = a.in[31]; K = 256; N = 1024; WT = (bf16_t*)(ws + WS_WPP); }
        const int nblk = N / 32, kb = r / nblk, nb = r % nblk, k0 = 64 * kb, n0 = 32 * nb;
        const int drow0 = (mode == 0) ? n0 : ((n0 >> 7) * 256 + (mode == 2 ? 128 : 0) + (n0 & 127));
        p0_transpose_item(W, K, N, WT, k0, n0, drow0, gain, scr, lane);
    }
    bf16_t* XB = (bf16_t*)(ws + WS_XB); float* RS = (float*)(ws + WS_RS); bf16_t* PB = (bf16_t*)(ws + WS_PB);
    for (int row = gw; row < M; row += NGW) {
        const float* xr = row < MP ? a.in[0] + (size_t)row * D : a.in[1] + (size_t)(row - MP) * D;
        const float* pr = row < MP ? a.in[6] + (size_t)row * PLE : a.in[7] + (size_t)(row - MP) * PLE;
        float ss = 0.f;
#pragma unroll
        for (int j = 0; j < 4; ++j) { const f32x4 v = *(const f32x4*)(xr + 4 * (lane + 64 * j)); ss += (v[0] * v[0] + v[1] * v[1]) + (v[2] * v[2] + v[3] * v[3]);
            u32x2 w; w.x = cvt_pk_bf16(v[0], v[1]); w.y = cvt_pk_bf16(v[2], v[3]); *(u32x2*)(XB + (size_t)row * D + 4 * (lane + 64 * j)) = w; }
        ss = wave_sum(ss);
        if (lane == 0) RS[row] = 1.0f / sqrtf(ss * (1.0f / D) + EPS);
        { const f32x4 v = *(const f32x4*)(pr + 4 * lane); u32x2 w; w.x = cvt_pk_bf16(v[0], v[1]); w.y = cvt_pk_bf16(v[2], v[3]); *(u32x2*)(PB + (size_t)row * PLE + 4 * lane) = w; }
    }
    const int gt = gw * 64 + lane;
    if (gt < 2048) {
        const int g = gt >> 6;
        const float dt = expf(a.in[13][g]); const float are = a.in[11][gt], aim = a.in[12][gt];
        const float mag = expf(are * dt); float sn, cs; sincos_rr(aim * dt, sn, cs);
        const float lre = mag * cs, lim = mag * sn;
        const float den = are * are + aim * aim, nr = lre - 1.0f, ni = lim;
        const float fre = (nr * are + ni * aim) / den, fim = (ni * are - nr * aim) / den;
        float* LB = (float*)(ws + WS_LB); float* LB64 = (float*)(ws + WS_LB64); float* BB = (float*)(ws + WS_BB);
        LB[gt] = lre; LB[2048 + gt] = lim;
        float pr_ = lre, pi_ = lim;
#pragma unroll
        for (int i = 0; i < 6; ++i) { const float nr2 = pr_ * pr_ - pi_ * pi_, ni2 = 2.0f * pr_ * pi_; pr_ = nr2; pi_ = ni2; }
        LB64[gt] = pr_; LB64[2048 + gt] = pi_;
        const float* bre = a.in[14] + (size_t)gt * 16; const float* bim = a.in[15] + (size_t)gt * 16;
#pragma unroll
        for (int c = 0; c < 16; ++c) { const float br = bre[c], bi = bim[c]; BB[(size_t)gt * 16 + c] = fre * br - fim * bi; BB[32768 + (size_t)gt * 16 + c] = fre * bi + fim * br; }
    }
}

__device__ __forceinline__ void attn_item(int item, const Args& a, int lane) {
    asm volatile("" : "+v"(lane));
    float* out = a.out; unsigned char* ws = a.ws;
    const bool samp = item >= 4096;
    int b, h, qb, m0, P0;
    if (!samp) { b = item >> 9; h = (item >> 6) & 7; qb = item & 63; m0 = b * 2048 + qb * 32; P0 = qb * 32; }
    else { const int it = item - 4096; b = it >> 4; h = (it >> 1) & 7; qb = it & 1; m0 = MP + b * 64 + qb * 32; P0 = 4096 + qb * 32; }
    const int q = lane & 31, hi = lane >> 5;
    const bf16_t* Qp = (const bf16_t*)(ws + WS_Q) + (size_t)(m0 + q) * 512 + h * 64 + 8 * hi;
    bf16x8 qf[4];
#pragma unroll
    for (int ds = 0; ds < 4; ++ds) qf[ds] = *(const bf16x8*)(Qp + 16 * ds);
    f32x16 o0, o1;
#pragma unroll
    for (int r = 0; r < 16; ++r) { o0[r] = 0.f; o1[r] = 0.f; }
    float carry = 0.f;
    const int keyl = 16 * ((q >> 2) & 1) + 4 * (q >> 3) + (q & 3);
    const int Pq = P0 + q;
    for (int kt = P0 >> 5; kt >= 0; --kt) {
        const float* kp; const float* vp;
        if (!samp) { const size_t r0 = (size_t)(b * 2048 + kt * 32) * 512 + h * 64; kp = out + O_KP + r0; vp = out + O_VP + r0; }
        else if (kt < 128) { const size_t r0 = (size_t)(b * 4096 + kt * 32) * 512 + h * 64; kp = a.in[2] + r0; vp = a.in[3] + r0; }
        else { const size_t r0 = (size_t)(b * 64 + (kt - 128) * 32) * 512 + h * 64; kp = out + O_KS + r0; vp = out + O_VS + r0; }
        const float* kr = kp + (size_t)keyl * 512 + 8 * hi;
        f32x4 kx[8];
#pragma unroll
        for (int ds = 0; ds < 4; ++ds) { kx[2 * ds] = *(const f32x4*)(kr + 16 * ds); kx[2 * ds + 1] = *(const f32x4*)(kr + 16 * ds + 4); }
        float vx[2][2][8];
#pragma unroll
        for (int dh = 0; dh < 2; ++dh)
#pragma unroll
            for (int s = 0; s < 2; ++s)
#pragma unroll
                for (int kk = 0; kk < 8; ++kk) vx[dh][s][kk] = vp[(size_t)(16 * hi + 8 * s + kk) * 512 + 32 * dh + q];
        f32x16 st;
#pragma unroll
        for (int r = 0; r < 16; ++r) st[r] = 0.f;
#pragma unroll
        for (int ds = 0; ds < 4; ++ds) { const bf16x8 kf = __builtin_bit_cast(bf16x8, pack8(kx[2 * ds], kx[2 * ds + 1])); st = __builtin_amdgcn_mfma_f32_32x32x16_bf16(kf, qf[ds], st, 0, 0, 0); }
        float lk[16], zz[16]; float run = 0.f;
        const int s0 = 32 * kt + 16 * hi;
#pragma unroll
        for (int r = 15; r >= 0; --r) {
            const float z = st[r] * 0.125f; const bool vis = (s0 + r) < Pq;
            const float sp = fmaxf(z, 0.f) + __logf(1.0f + __expf(-fabsf(z)));
            const float l = vis ? -sp : 0.f;
            zz[r] = vis ? (z + l + run) : -1e30f;
            lk[r] = l; run += l;
        }
        const float oth = __shfl_xor(run, 32);
        const float add = carry + (hi == 0 ? oth : 0.f);
        float w[16];
#pragma unroll
        for (int r = 0; r < 16; ++r) w[r] = __expf(zz[r] + add);
        carry += run + oth;
        u32x4 wb0, wb1;
        wb0.x = cvt_pk_bf16(w[0], w[1]); wb0.y = cvt_pk_bf16(w[2], w[3]); wb0.z = cvt_pk_bf16(w[4], w[5]); wb0.w = cvt_pk_bf16(w[6], w[7]);
        wb1.x = cvt_pk_bf16(w[8], w[9]); wb1.y = cvt_pk_bf16(w[10], w[11]); wb1.z = cvt_pk_bf16(w[12], w[13]); wb1.w = cvt_pk_bf16(w[14], w[15]);
        const bf16x8 wf0 = __builtin_bit_cast(bf16x8, wb0), wf1 = __builtin_bit_cast(bf16x8, wb1);
#pragma unroll
        for (int dh = 0; dh < 2; ++dh) {
            u32x4 v0, v1;
            v0.x = cvt_pk_bf16(vx[dh][0][0], vx[dh][0][1]); v0.y = cvt_pk_bf16(vx[dh][0][2], vx[dh][0][3]); v0.z = cvt_pk_bf16(vx[dh][0][4], vx[dh][0][5]); v0.w = cvt_pk_bf16(vx[dh][0][6], vx[dh][0][7]);
            v1.x = cvt_pk_bf16(vx[dh][1][0], vx[dh][1][1]); v1.y = cvt_pk_bf16(vx[dh][1][2], vx[dh][1][3]); v1.z = cvt_pk_bf16(vx[dh][1][4], vx[dh][1][5]); v1.w = cvt_pk_bf16(vx[dh][1][6], vx[dh][1][7]);
            if (dh == 0) { o0 = __builtin_amdgcn_mfma_f32_32x32x16_bf16(__builtin_bit_cast(bf16x8, v0), wf0, o0, 0, 0, 0); o0 = __builtin_amdgcn_mfma_f32_32x32x16_bf16(__builtin_bit_cast(bf16x8, v1), wf1, o0, 0, 0, 0); }
            else { o1 = __builtin_amdgcn_mfma_f32_32x32x16_bf16(__builtin_bit_cast(bf16x8, v0), wf0, o1, 0, 0, 0); o1 = __builtin_amdgcn_mfma_f32_32x32x16_bf16(__builtin_bit_cast(bf16x8, v1), wf1, o1, 0, 0, 0); }
        }
        if (__all(carry < -104.0f)) break;
    }
    bf16_t* Op = (bf16_t*)(ws + WS_OA) + (size_t)(m0 + q) * 512 + h * 64;
#pragma unroll
    for (int j = 0; j < 4; ++j) {
        u32x2 w0, w1; w0.x = cvt_pk_bf16(o0[4 * j], o0[4 * j + 1]); w0.y = cvt_pk_bf16(o0[4 * j + 2], o0[4 * j + 3]); w1.x = cvt_pk_bf16(o1[4 * j], o1[4 * j + 1]); w1.y = cvt_pk_bf16(o1[4 * j + 2], o1[4 * j + 3]);
        *(u32x2*)(Op + 8 * j + 4 * hi) = w0; *(u32x2*)(Op + 32 + 8 * j + 4 * hi) = w1;
    }
}

template <bool PASS2>
__device__ __forceinline__ void ssm_item(int item, const Args& a, LAS unsigned char* wl, int lane) {
    asm volatile("" : "+v"(lane));
    unsigned char* ws = a.ws; float* out = a.out;
    int b, chunk, g, row0; bool samp = false;
    if (!PASS2) { b = item / 992; const int rem = item - b * 992; chunk = rem >> 5; g = rem & 31; row0 = b * 2048 + chunk * 64; }
    else if (item < 8192) { b = item >> 10; chunk = (item >> 5) & 31; g = item & 31; row0 = b * 2048 + chunk * 64; }
    else { const int it = item - 8192; b = it >> 5; g = it & 31; chunk = 0; row0 = MP + b * 64; samp = true; }
    const int p = lane, gp = g * 64 + p;
    const float* LB = (const float*)(ws + WS_LB); const float* BB = (const float*)(ws + WS_BB);
    const float lre = LB[gp], lim = LB[2048 + gp];
    float bbr[16], bbi[16];
#pragma unroll
    for (int c4 = 0; c4 < 4; ++c4) { const f32x4 x = *(const f32x4*)(BB + (size_t)gp * 16 + 4 * c4), y = *(const f32x4*)(BB + 32768 + (size_t)gp * 16 + 4 * c4);
#pragma unroll
        for (int e = 0; e < 4; ++e) { bbr[4 * c4 + e] = x[e]; bbi[4 * c4 + e] = y[e]; } }
    LAS float* ubuf = (LAS float*)wl;
    LAS bf16_t* sbuf = (LAS bf16_t*)(wl + 4096);
    const float* U = (const float*)(ws + WS_U);
#pragma unroll
    for (int i = 0; i < 4; ++i) { const int t = (lane >> 2) + 16 * i; *(LAS f32x4*)(ubuf + t * 16 + (lane & 3) * 4) = *(const f32x4*)(U + (size_t)(row0 + t) * 512 + g * 16 + (lane & 3) * 4); }
    float sre = 0.f, sim = 0.f;
    bf16x8 cf[4]; float dv = 0.f;
    if (PASS2) {
        if (samp) { sre = a.in[4][(size_t)(b * 32 + g) * 64 + p]; sim = a.in[5][(size_t)(b * 32 + g) * 64 + p]; }
        else {
            const float* LB64 = (const float*)(ws + WS_LB64); const float l6r = LB64[gp], l6i = LB64[2048 + gp];
            const float* E = (const float*)(ws + WS_E) + (size_t)b * 32 * 4096 + gp;
            for (int j = 0; j < chunk; ++j) { const float er = E[(size_t)j * 4096], ei = E[(size_t)j * 4096 + 2048]; const float nr = l6r * sre - l6i * sim + er, ni = l6r * sim + l6i * sre + ei; sre = nr; sim = ni; }
        }
        const int n = lane & 15, kg = lane >> 4;
#pragma unroll
        for (int ks = 0; ks < 4; ++ks) {
            const float* src = (ks < 2 ? a.in[16] : a.in[17]) + (size_t)(g * 16 + n) * 64 + (32 * (ks & 1) + 8 * kg);
            f32x4 x0 = *(const f32x4*)src, x1 = *(const f32x4*)(src + 4); if (ks >= 2) { x0 = -x0; x1 = -x1; }
            cf[ks] = __builtin_bit_cast(bf16x8, pack8(x0, x1));
        }
        dv = a.in[18][g * 16 + n];
    }
    asm volatile("s_waitcnt lgkmcnt(0)" ::: "memory");
    for (int tb = 0; tb < 4; ++tb) {
#pragma unroll
        for (int tt = 0; tt < 16; ++tt) {
            const LAS f32x4* up = (const LAS f32x4*)(ubuf + (tb * 16 + tt) * 16);
            const f32x4 u0 = up[0], u1 = up[1], u2 = up[2], u3 = up[3];
            float br = 0.f, bi = 0.f;
#pragma unroll
            for (int e = 0; e < 4; ++e) { br += bbr[e] * u0[e]; bi += bbi[e] * u0[e]; }
#pragma unroll
            for (int e = 0; e < 4; ++e) { br += bbr[4 + e] * u1[e]; bi += bbi[4 + e] * u1[e]; }
#pragma unroll
            for (int e = 0; e < 4; ++e) { br += bbr[8 + e] * u2[e]; bi += bbi[8 + e] * u2[e]; }
#pragma unroll
            for (int e = 0; e < 4; ++e) { br += bbr[12 + e] * u3[e]; bi += bbi[12 + e] * u3[e]; }
            const float nr = lre * sre - lim * sim + br, ni = lre * sim + lim * sre + bi; sre = nr; sim = ni;
            if (PASS2) { sbuf[tt * 136 + p] = (bf16_t)f2bf(sre); sbuf[tt * 136 + 64 + p] = (bf16_t)f2bf(sim); }
        }
        if (PASS2) {
            f32x4 y = (f32x4){0.f, 0.f, 0.f, 0.f};
            const int n = lane & 15, kg = lane >> 4;
#pragma unroll
            for (int ks = 0; ks < 4; ++ks) { const bf16x8 af = *(const LAS bf16x8*)(sbuf + n * 136 + 32 * ks + 8 * kg); y = __builtin_amdgcn_mfma_f32_16x16x32_bf16(af, cf[ks], y, 0, 0, 0); }
            bf16_t* YS = (bf16_t*)(ws + WS_YS);
#pragma unroll
            for (int r = 0; r < 4; ++r) {
                const int t = tb * 16 + 4 * kg + r; const float yv = y[r] + dv * ubuf[t * 16 + n];
                const float ge = yv * sigm(1.5957691216057308f * (yv + 0.044715f * yv * yv * yv));
                YS[(size_t)(row0 + t) * 512 + g * 16 + n] = (bf16_t)f2bf(ge);
            }
        }
    }
    if (!PASS2) { float* E = (float*)(ws + WS_E) + ((size_t)b * 32 + chunk) * 4096 + gp; E[0] = sre; E[2048] = sim; }
    else if (samp) { out[O_SRS + (size_t)(b * 32 + g) * 64 + p] = sre; out[O_SIS + (size_t)(b * 32 + g) * 64 + p] = sim; }
    else if (chunk == 31) { out[O_SRP + (size_t)(b * 32 + g) * 64 + p] = sre; out[O_SIP + (size_t)(b * 32 + g) * 64 + p] = sim; }
    asm volatile("s_waitcnt lgkmcnt(0)" ::: "memory");
}

__device__ __forceinline__ void row_pass(int mode, const Args& a, int gw, int NGW, int lane) {
    asm volatile("" : "+v"(lane));
    unsigned char* ws = a.ws; float* Y = a.out + O_Y;
    const float* T = (const float*)(ws + WS_T);
    const float* ssq = (const float*)(ws + (mode == 0 ? WS_SSQ1 : mode == 1 ? WS_SSQ2 : WS_SSQ3));
    const float* gain = a.in[mode == 0 ? 9 : mode == 1 ? 24 : 29];
    bf16_t* XB = (bf16_t*)(ws + WS_XB); float* RS = (float*)(ws + WS_RS);
    f32x4 gv[4];
#pragma unroll
    for (int j = 0; j < 4; ++j) gv[j] = *(const f32x4*)(gain + 4 * (lane + 64 * j));
    for (int row = gw; row < M; row += NGW) {
        const float* xr = (mode == 0) ? (row < MP ? a.in[0] + (size_t)row * D : a.in[1] + (size_t)(row - MP) * D) : Y + (size_t)row * D;
        const float rs = 1.0f / sqrtf(ssq[row] * (1.0f / D) + EPS);
        float ss = 0.f;
#pragma unroll
        for (int j = 0; j < 4; ++j) {
            const int c = 4 * (lane + 64 * j);
            const f32x4 x = *(const f32x4*)(xr + c), t = *(const f32x4*)(T + (size_t)row * D + c);
            const f32x4 v = x + t * gv[j] * rs;
            *(f32x4*)(Y + (size_t)row * D + c) = v;
            if (mode < 2) { ss += (v[0] * v[0] + v[1] * v[1]) + (v[2] * v[2] + v[3] * v[3]); u32x2 w; w.x = cvt_pk_bf16(v[0], v[1]); w.y = cvt_pk_bf16(v[2], v[3]); *(u32x2*)(XB + (size_t)row * D + c) = w; }
        }
        if (mode < 2) { ss = wave_sum(ss); if (lane == 0) RS[row] = 1.0f / sqrtf(ss * (1.0f / D) + EPS); }
    }
}

#define XB_TMO      128
#define XB_XCNT(j)  (256  + 64 * (j))
#define XB_XSUB(j)  (1280 + 64 * (j))
#define XB_XGEN(j)  (2304 + 64 * (j))
#define XB_TOP      3328
#define XB_TOPGEN   3392
#define XCD_BAR_WORDS 3456
#define XB_SPIN_CAP (1u << 18)
__device__ __forceinline__ unsigned xb_ld(unsigned* p)              { return __hip_atomic_load(p, __ATOMIC_RELAXED, __HIP_MEMORY_SCOPE_AGENT); }
__device__ __forceinline__ unsigned xb_add(unsigned* p, unsigned v) { return __hip_atomic_fetch_add(p, v, __ATOMIC_RELAXED, __HIP_MEMORY_SCOPE_AGENT); }
__device__ __forceinline__ unsigned xb_xcc_id() { return (unsigned)__builtin_amdgcn_s_getreg((3 << 11) | 20) & 0xFu; }
#define XB_SPIN(cond, bar) do { unsigned _sp = 0; while (cond) { __builtin_amdgcn_s_sleep(1); \
    if ((++_sp & 255u) == 0u) { if (xb_ld(&(bar)[XB_TMO])) break; if (_sp > XB_SPIN_CAP) { atomicAdd(&(bar)[XB_TMO], 1u); break; } } } } while (0)
struct XcdBarrier { unsigned* bar; unsigned x; volatile LAS unsigned* st; };
__device__ __forceinline__ XcdBarrier xcd_barrier_post(unsigned* bar, volatile LAS unsigned* st) {
    XcdBarrier b; b.bar = bar; b.x = xb_xcc_id(); b.st = st;
    if (threadIdx.x == 0) (void)xb_add(&bar[XB_XCNT(b.x)], 1u);
    return b;
}
__device__ __forceinline__ void xcd_barrier_complete(unsigned* bar, unsigned x, unsigned& nloc, unsigned& nx) {
    const unsigned G = gridDim.x * gridDim.y * gridDim.z;
    unsigned sum, cnt, mine, sp = 0u;
    for (;;) {
        sum = 0u; cnt = 0u; mine = 0u;
#pragma unroll
        for (unsigned j = 0; j < 16; ++j) { const unsigned c = xb_ld(&bar[XB_XCNT(j)]); sum += c; cnt += (c > 0u) ? 1u : 0u; mine = (j == x) ? c : mine; }
        if (sum == G) break;
        __builtin_amdgcn_s_sleep(1);
        if ((++sp & 255u) == 0u) { if (xb_ld(&bar[XB_TMO])) break; if (sp > XB_SPIN_CAP) { atomicAdd(&bar[XB_TMO], 1u); break; } }
    }
    nloc = mine > 0u ? mine : 1u; nx = cnt > 0u ? cnt : 1u;
}
__device__ __forceinline__ void xcd_barrier(const XcdBarrier& b) {
    asm volatile("s_waitcnt vmcnt(0)" ::: "memory");
    __syncthreads();
    if (threadIdx.x == 0) {
        unsigned* bar = b.bar;
        __builtin_amdgcn_s_waitcnt(0);
        unsigned nloc = b.st[0], nx = b.st[1];
        if (nloc == 0u) { xcd_barrier_complete(bar, b.x, nloc, nx); b.st[0] = nloc; b.st[1] = nx; }
        const unsigned old = xb_add(&bar[XB_XSUB(b.x)], 1u);
        const unsigned gen = old / nloc;
        if (old + 1u == (gen + 1u) * nloc) {
            __builtin_amdgcn_fence(__ATOMIC_RELEASE, "agent");
            asm volatile("s_waitcnt vmcnt(0)" ::: "memory");
            const unsigned og = xb_add(&bar[XB_TOP], 1u);
            const unsigned tg = og / nx;
            if (og + 1u == (tg + 1u) * nx) xb_add(&bar[XB_TOPGEN], 1u);
            else XB_SPIN(xb_ld(&bar[XB_TOPGEN]) == tg, bar);
            __builtin_amdgcn_fence(__ATOMIC_ACQUIRE, "agent");
            xb_add(&bar[XB_XGEN(b.x)], 1u);
            asm volatile("s_waitcnt vmcnt(0)" ::: "memory");
        } else {
            XB_SPIN(xb_ld(&bar[XB_XGEN(b.x)]) == gen, bar);
            __builtin_amdgcn_fence(__ATOMIC_ACQUIRE, "agent");
            asm volatile("s_waitcnt vmcnt(0)" ::: "memory");
        }
    }
    __syncthreads();
}

__global__ void __launch_bounds__(512, 2) fwd_kernel(Args a) {
    extern __shared__ __attribute__((aligned(16))) unsigned char lds_raw[];
    LAS unsigned char* lds = (LAS unsigned char*)lds_raw;
    cg::grid_group grid = cg::this_grid();
    const int tid = threadIdx.x, lane = tid & 63, wave = __builtin_amdgcn_readfirstlane(tid >> 6);
    const int G = gridDim.x, gw = blockIdx.x * 8 + wave, NGW = G * 8;
    unsigned char* ws = a.ws;
    if (tid < 4) ((LAS unsigned*)(lds + 131072))[tid] = 0u;
    __syncthreads();
    const XcdBarrier xbar = xcd_barrier_post((unsigned*)(ws + WS_BAR), (volatile LAS unsigned*)(lds + 131072));
#define GEMM1(Ap, Bp, Kv, nNv, Tv, SSQ) do { pg8::Sched S; S.nd = 1; S.G = G; S.c = blockIdx.x; S.d0 = pg8::GDesc{(const bf16_t*)(ws + (Ap)), (const bf16_t*)(ws + (Bp)), (Kv), (nNv), (Tv)}; S.d1 = S.d0; S.d2 = S.d0; \
        pg8::Epi<(1 << (Tv))> E; E.out = a.out; E.ws = ws; E.ssq = (float*)(ws + (SSQ)); pg8::gemm_phase(lds, S, E); } while (0)
    phase_prep(a, lds, gw, NGW, wave, lane);
    grid.sync();
    GEMM1(WS_XB, WS_WIN, 1024, 16, pg8::T_IN, WS_SSQ1);
    xcd_barrier(xbar);
    for (int it = gw; it < 4352 + 7936; it += NGW) { if (it < 4352) attn_item(it, a, lane); else ssm_item<false>(it - 4352, a, lds + wave * 16384, lane); }
    xcd_barrier(xbar);
    for (int it = gw; it < 8704; it += NGW) ssm_item<true>(it, a, lds + wave * 16384, lane);
    xcd_barrier(xbar);
    { pg8::Sched S; S.nd = 3; S.G = G; S.c = blockIdx.x;
      S.d0 = pg8::GDesc{(const bf16_t*)(ws + WS_OA), (const bf16_t*)(ws + WS_WBA), 512, 4, pg8::T_BA};
      S.d1 = pg8::GDesc{(const bf16_t*)(ws + WS_YS), (const bf16_t*)(ws + WS_WGLU), 512, 2, pg8::T_GLU};
      S.d2 = pg8::GDesc{(const bf16_t*)(ws + WS_PB), (const bf16_t*)(ws + WS_WPP), 256, 4, pg8::T_PP};
      pg8::Epi<(1 << pg8::T_BA) | (1 << pg8::T_GLU) | (1 << pg8::T_PP)> E; E.out = a.out; E.ws = ws; E.ssq = nullptr; pg8::gemm_phase(lds, S, E); }
    xcd_barrier(xbar);
    GEMM1(WS_OS, WS_WBS, 512, 4, pg8::T_BS, WS_SSQ1);
    xcd_barrier(xbar);
    GEMM1(WS_MG, WS_WOUT, 1024, 4, pg8::T_OUT, WS_SSQ1);
    xcd_barrier(xbar);
    row_pass(0, a, gw, NGW, lane);
    xcd_barrier(xbar);
    GEMM1(WS_XB, WS_WGU, 1024, 22, pg8::T_GU, WS_SSQ1);
    xcd_barrier(xbar);
    GEMM1(WS_H, WS_WDN, 2816, 4, pg8::T_OUT, WS_SSQ2);
    xcd_barrier(xbar);
    row_pass(1, a, gw, NGW, lane);
    xcd_barrier(xbar);
    GEMM1(WS_XB, WS_WPG, 1024, 4, pg8::T_PG, WS_SSQ3);
    xcd_barrier(xbar);
    row_pass(2, a, gw, NGW, lane);
#undef GEMM1
}

extern "C" void kernel_launch(void* const* d_in, const int* in_sizes, int n_in, void* d_out, int out_size, void* d_ws, size_t ws_size, hipStream_t stream) {
    static int grid = 0;
    if (grid == 0) {
        if (n_in != 32 || ws_size < WS_END) { fprintf(stderr, "kernel_launch: unexpected n_in %d / ws_size %zu\n", n_in, ws_size); grid = -1; return; }
        int dev = 0, cus = 0, per_cu = 0;
        hipGetDevice(&dev); hipDeviceGetAttribute(&cus, hipDeviceAttributeMultiprocessorCount, dev);
        hipFuncSetAttribute((const void*)fwd_kernel, hipFuncAttributeMaxDynamicSharedMemorySize, LDS_BYTES);
        hipOccupancyMaxActiveBlocksPerMultiprocessor(&per_cu, (const void*)fwd_kernel, 512, LDS_BYTES);
        if (per_cu < 1) per_cu = 1;
        grid = cus * per_cu;
        (void)hipGetLastError();
    }
    if (grid < 0) return;
    hipMemsetAsync((char*)d_ws + WS_CTL, 0, CTL_BYTES, stream);
    Args a{};
    for (int i = 0; i < 32; ++i) a.in[i] = (const float*)d_in[i];
    a.out = (float*)d_out; a.ws = (unsigned char*)d_ws;
    void* args[] = {&a};
    hipError_t e = hipLaunchCooperativeKernel((const void*)fwd_kernel, dim3(grid), dim3(512), args, LDS_BYTES, stream);
    if (e != hipSuccess) fprintf(stderr, "cooperative launch failed: %s (grid %d)\n", hipGetErrorString(e), grid);
}
```
